# Optimizing an MI355X kernel written in HIP

```python
import jax, jax.numpy as jnp
from jax import lax
import numpy as np

D_MODEL = 1024
BATCH = 8
SEQ = 2048
DEPTH = 2
DEC_BATCH = 128
DEC_SEQ = 1
PAST_LEN = 16384
PAGE_SIZE = 128

MIX_WIDTH = D_MODEL
HEAD_DIM = 64
W_A = D_MODEL // 4
W_B = 3 * D_MODEL // 8
W_C = MIX_WIDTH - W_A - W_B
POOL_WINDOWS = (2, 4, 8, 16)
N_POOL_GROUPS = 4
POOL_GROUP = W_A // N_POOL_GROUPS
POOL_HIST = max(POOL_WINDOWS) - 1
CONV_B_WIDTH = 31
CONV_C_WIDTH = 3
PLE_DIM = 256
EPS = 1e-6
IN_COLS = 2 * W_A + 3 * W_B + 4 * W_C

kernel_name = "hybrid_pool_conformer_shortconv_step"


def _rmsnorm(x, g):
    xf = x.astype(jnp.float32)
    y = xf * lax.rsqrt(jnp.mean(xf * xf, axis=-1, keepdims=True) + EPS)
    return (y * g.astype(jnp.float32)).astype(x.dtype)


def _layernorm(x, g, b):
    xf = x.astype(jnp.float32)
    mu = jnp.mean(xf, axis=-1, keepdims=True)
    xc = xf - mu
    var = jnp.mean(xc * xc, axis=-1, keepdims=True)
    y = xc * lax.rsqrt(var + EPS) * g.astype(jnp.float32) + b.astype(jnp.float32)
    return y.astype(x.dtype)


def _causal_dwconv(hist, u, w):
    k, c = w.shape
    z = jnp.concatenate([hist.astype(u.dtype), u], axis=1)
    out = lax.conv_general_dilated(
        z, w.astype(u.dtype)[:, None, :], window_strides=(1,), padding='VALID',
        dimension_numbers=('NWC', 'WIO', 'NWC'), feature_group_count=c)
    return out, z[:, z.shape[1] - (k - 1):]


def _pool_mixer(hist, v, pos0, w_mix, scale):
    bsz, t_len, _ = v.shape
    z = jnp.concatenate([hist.astype(v.dtype), v], axis=1)
    zf = z.astype(jnp.float32)
    cs = jnp.concatenate([jnp.zeros((bsz, 1, W_A), jnp.float32),
                          jnp.cumsum(zf, axis=1)], axis=1)
    t = jnp.arange(t_len)
    outs = []
    for g, w in enumerate(POOL_WINDOWS):
        csg = cs[:, :, g * POOL_GROUP:(g + 1) * POOL_GROUP]
        s = csg[:, POOL_HIST + 1:POOL_HIST + 1 + t_len] - csg[:, POOL_HIST + 1 - w:POOL_HIST + 1 - w + t_len]
        cnt = jnp.minimum(w, pos0 + t + 1).astype(jnp.float32)
        outs.append(s / cnt[None, :, None])
    pooled = jnp.concatenate(outs, axis=-1) - v.astype(jnp.float32)
    pooled = pooled.reshape(bsz, t_len, N_POOL_GROUPS, POOL_GROUP)
    mixed = jnp.einsum('btgc,gcd->btgd', pooled, w_mix.astype(jnp.float32))
    mixed = mixed.reshape(bsz, t_len, W_A) * scale.astype(jnp.float32)
    return mixed.astype(v.dtype), z[:, z.shape[1] - POOL_HIST:]


def _layer(x, pe, h_pool, h_conv, h_sconv, pos0, norm_g, w_in, w_pool_mix, pool_scale,
           conv_b_w, conv_b_b, ln_b_g, ln_b_b, sconv_w, w_out, w_ple, w_ple_gate):
    h = _rmsnorm(x, norm_g)
    proj = h @ w_in
    sizes = [W_A, W_A, W_B, W_B, W_B, W_C, W_C, W_C, W_C]
    idx = [int(i) for i in np.cumsum(sizes)[:-1]]
    v_a, z_a, a_b, g_b, z_b, x_c, b_c, c_c, z_c = jnp.split(proj, idx, axis=-1)
    y_a, n_pool = _pool_mixer(h_pool, v_a, pos0, w_pool_mix, pool_scale)
    y_a = y_a * jax.nn.silu(z_a)
    u_b = a_b * jax.nn.sigmoid(g_b)
    c_b, n_conv = _causal_dwconv(h_conv, u_b, conv_b_w)
    c_b = c_b + conv_b_b
    y_b = jax.nn.silu(_layernorm(c_b, ln_b_g, ln_b_b)) * jax.nn.silu(z_b)
    u_c = c_c * x_c
    s_c, n_sconv = _causal_dwconv(h_sconv, u_c, sconv_w)
    y_c = b_c * s_c * jax.nn.silu(z_c)
    y = jnp.concatenate([y_a, y_b, y_c], axis=-1) @ w_out
    x = x + y
    gate = jax.nn.sigmoid((x @ w_ple_gate).astype(jnp.float32)).astype(x.dtype)
    x = x + (pe @ w_ple) * gate
    return x, n_pool, n_conv, n_sconv


def setup_inputs(seed: int = 0) -> dict:
    key = jax.random.key(seed)
    ks = jax.random.split(key, 24)
    f32 = jnp.float32
    nrm = lambda k, s, sc: jax.random.normal(k, s, f32) * sc
    return {
        "x_prompt": nrm(ks[0], (BATCH, SEQ, D_MODEL), 1.0),
        "x_sample": nrm(ks[1], (DEC_BATCH, DEC_SEQ, D_MODEL), 1.0),
        "state_pool": nrm(ks[2], (DEPTH, DEC_BATCH, POOL_HIST, W_A), 1.0),
        "state_conv": nrm(ks[3], (DEPTH, DEC_BATCH, CONV_B_WIDTH - 1, W_B), 0.5),
        "state_sconv": nrm(ks[4], (DEPTH, DEC_BATCH, CONV_C_WIDTH - 1, W_C), 1.0),
        "p_prompt": nrm(ks[5], (DEPTH, BATCH, SEQ, PLE_DIM), 1.0),
        "p_sample": nrm(ks[6], (DEPTH, DEC_BATCH, DEC_SEQ, PLE_DIM), 1.0),
        "norm_g": 1.0 + nrm(ks[7], (DEPTH, D_MODEL), 0.02),
        "w_in": nrm(ks[8], (DEPTH, D_MODEL, IN_COLS), D_MODEL ** -0.5),
        "w_pool_mix": nrm(ks[9], (DEPTH, N_POOL_GROUPS, POOL_GROUP, POOL_GROUP), POOL_GROUP ** -0.5),
        "pool_scale": 1.0 + nrm(ks[10], (DEPTH, W_A), 0.02),
        "conv_b_w": nrm(ks[11], (DEPTH, CONV_B_WIDTH, W_B), CONV_B_WIDTH ** -0.5),
        "conv_b_b": nrm(ks[12], (DEPTH, W_B), 0.02),
        "ln_b_g": 1.0 + nrm(ks[13], (DEPTH, W_B), 0.02),
        "ln_b_b": nrm(ks[14], (DEPTH, W_B), 0.02),
        "sconv_w": nrm(ks[15], (DEPTH, CONV_C_WIDTH, W_C), CONV_C_WIDTH ** -0.5),
        "w_out": nrm(ks[16], (DEPTH, MIX_WIDTH, D_MODEL), MIX_WIDTH ** -0.5),
        "w_ple": nrm(ks[17], (DEPTH, PLE_DIM, D_MODEL), PLE_DIM ** -0.5),
        "w_ple_gate": nrm(ks[18], (DEPTH, D_MODEL, D_MODEL), D_MODEL ** -0.5),
        "final_norm_g": 1.0 + nrm(ks[19], (D_MODEL,), 0.02),
    }


def reference(x_prompt, x_sample, state_pool, state_conv, state_sconv, p_prompt, p_sample,
              norm_g, w_in, w_pool_mix, pool_scale, conv_b_w, conv_b_b, ln_b_g, ln_b_b,
              sconv_w, w_out, w_ple, w_ple_gate, final_norm_g):
    xp, xs = x_prompt, x_sample
    bp = x_prompt.shape[0]
    dt = x_prompt.dtype
    pool_p, pool_s, conv_p, conv_s, sconv_p, sconv_s = [], [], [], [], [], []
    for i in range(DEPTH):
        lw = (norm_g[i], w_in[i], w_pool_mix[i], pool_scale[i], conv_b_w[i], conv_b_b[i],
              ln_b_g[i], ln_b_b[i], sconv_w[i], w_out[i], w_ple[i], w_ple_gate[i])
        xp, a, b, c = _layer(
            xp, p_prompt[i],
            jnp.zeros((bp, POOL_HIST, W_A), dt),
            jnp.zeros((bp, CONV_B_WIDTH - 1, W_B), dt),
            jnp.zeros((bp, CONV_C_WIDTH - 1, W_C), dt),
            0, *lw)
        pool_p.append(a); conv_p.append(b); sconv_p.append(c)
        xs, a, b, c = _layer(xs, p_sample[i], state_pool[i], state_conv[i], state_sconv[i],
                             PAST_LEN, *lw)
        pool_s.append(a); conv_s.append(b); sconv_s.append(c)
    y_prompt = _rmsnorm(xp, final_norm_g)
    y_sample = _rmsnorm(xs, final_norm_g)
    return (y_prompt, y_sample,
            jnp.stack(pool_p), jnp.stack(pool_s),
            jnp.stack(conv_p), jnp.stack(conv_s),
            jnp.stack(sconv_p), jnp.stack(sconv_s))
```

```cpp
#include <hip/hip_runtime.h>
#include <cstdio>
#include <cstdint>

#ifndef MK_N_LAUNCHES
#define MK_N_LAUNCHES 1
#endif

namespace pg8 {
#define PG8_LAS __attribute__((address_space(3)))
typedef unsigned short bf16_t;
typedef short bf16x8 __attribute__((ext_vector_type(8)));
typedef float f32x4 __attribute__((ext_vector_type(4)));
typedef unsigned u32x4 __attribute__((ext_vector_type(4)));
typedef unsigned u32x2 __attribute__((ext_vector_type(2)));
constexpr int BM = 256, BK = 64, HALF = 128, HTB = HALF * BK * 2  , STAGE_BYTES = 8 * HTB, NXCD = 8, WGM = 8;

__host__ __device__ __forceinline__ int lds_byte(int r, int c) { const int st = (r >> 4) * 2 + (c >> 5), rr = r & 15, cc = c & 31, ob = rr * 64 + cc * 2; return st * 1024 + (ob ^ (((ob >> 9) & 1) << 5)); }
__host__ __device__ __forceinline__ void stage_rc(int b, int& R, int& C) { const int st = b / 1024, sb = b % 1024, swz = sb ^ (((sb >> 9) & 1) << 5); R = (st >> 1) * 16 + swz / 64; C = (st & 1) * 32 + (swz % 64) / 2; }
__host__ __device__ __forceinline__ int perm32(int rho) { const int n = rho >> 4, i = rho & 15; return 8 * (i >> 2) + 4 * n + (i & 3); }

struct Unit { int pm, pn; };
struct Gemm { const bf16_t* A; const bf16_t* Bt; int M, N, K; };

struct StaticOrder {
    int nM, nN, nwg, G, c;
    __host__ __device__ void init(int M, int N, int G_, int c_) { nM = M / BM; nN = N / BM; nwg = nM * nN; G = G_; c = c_; }
    __host__ __device__ bool next(int i, Unit& u) const {
        const long L = (long)i * G + c; if (L >= nwg) return false;
        int wgid = (int)L; { const int q = nwg / NXCD, r = nwg % NXCD, xcd = wgid % NXCD, off = wgid / NXCD; wgid = (xcd < r ? xcd * (q + 1) : r * (q + 1) + (xcd - r) * q) + off; }
        const int nig = WGM * nN, gid = wgid / nig, fm = gid * WGM, gsz = (nM - fm) < WGM ? (nM - fm) : WGM;
        u.pm = fm + ((wgid % nig) % gsz); u.pn = (wgid % nig) / gsz; return true;
    }
    __device__ __forceinline__ void a_ready(const Unit&) const {}
    __device__ __forceinline__ void done(const Unit&) const {}
};

__device__ __forceinline__ unsigned cvt_pk_bf16(float lo, float hi) { unsigned r; asm volatile("v_cvt_pk_bf16_f32 %0, %1, %2" : "=v"(r) : "v"(lo), "v"(hi)); return r; }

template <class Epi, class Sched, bool ALIGN_EPI = false, bool SP2 = false>
__device__ __forceinline__ void gemm_phase(PG8_LAS unsigned char* lds, const Gemm g, const Sched& S, const Epi& E) {
    int tz0; asm volatile("s_mov_b32 %0, 0" : "=s"(tz0));
    const int tid = threadIdx.x + tz0, wid = __builtin_amdgcn_readfirstlane(tid >> 6), lane = tid & 63, wr = wid >> 2, wc = wid & 3, fr = lane & 15, fq = lane >> 4;
    const int K = g.K, nt = K / BK;
    unsigned voffA[2], voffB[2];
#pragma unroll
    for (int i = 0; i < 2; ++i) { int R, C; stage_rc(tid * 16 + i * 8192, R, C); const int Rb = Epi::PERM ? ((R & ~31) + perm32(R & 31)) : R;
        voffA[i] = (unsigned)(R * K + C) * 2u; voffB[i] = (unsigned)(Rb * K + C) * 2u; }
    const size_t kstep = (size_t)(BK * 2);
    const size_t hstep = (size_t)HALF * K * 2;
    const size_t tstep = 2 * hstep;
    const unsigned ldsw = (unsigned)wid * 1024u;
    const int aoff = lds_byte(wr * 64 + fr, fq * 8), boff = lds_byte(wc * 32 + fr, fq * 8);
#define PG8_SA(b, h) (((b) * 2 + (h)) * HTB)
#define PG8_SB(b, h) ((4 + (b) * 2 + (h)) * HTB)
#define PG8_STAGE(bufoff, gbase, voff) do { _Pragma("unroll") for (int _i = 0; _i < 2; ++_i) \
        __builtin_amdgcn_global_load_lds((const unsigned*)((const char*)(gbase) + (voff)[_i]), (PG8_LAS unsigned*)(lds + (bufoff) + ldsw + _i * 8192), 16, 0, 0); } while (0)
#define PG8_LDA(dst, b, h) do { _Pragma("unroll") for (int m = 0; m < 4; ++m) _Pragma("unroll") for (int k = 0; k < 2; ++k) dst[m][k] = *(const PG8_LAS bf16x8*)(lds + PG8_SA(b, h) + aoff + m * 2048 + k * 1024); } while (0)
#define PG8_LDB(dst, b, h) do { _Pragma("unroll") for (int n = 0; n < 2; ++n) _Pragma("unroll") for (int k = 0; k < 2; ++k) dst[n][k] = *(const PG8_LAS bf16x8*)(lds + PG8_SB(b, h) + boff + n * 2048 + k * 1024); } while (0)
#define PG8_MMA(ai, bj, At, Bt) do { __builtin_amdgcn_s_setprio(1); _Pragma("unroll") for (int m = 0; m < 4; ++m) _Pragma("unroll") for (int n = 0; n < 2; ++n) _Pragma("unroll") for (int k = 0; k < 2; ++k) \
        acc[ai][bj][m][n] = __builtin_amdgcn_mfma_f32_16x16x32_bf16(Bt[n][k], At[m][k], acc[ai][bj][m][n], 0, 0, 0); __builtin_amdgcn_s_setprio(0); } while (0)
#define PG8_WAIT_V(n) asm volatile("s_waitcnt vmcnt(" #n ")" ::: "memory")
#define PG8_WAIT_L(n) asm volatile("s_waitcnt lgkmcnt(" #n ")" ::: "memory")
#define PG8_BAR __builtin_amdgcn_s_barrier()
#define PG8_SCHED __builtin_amdgcn_sched_barrier(0)
    Unit cur, nxt; int ui = 0;
    if (!S.next(0, cur)) return;
    f32x4 acc[2][2][4][2];
#pragma unroll
    for (int a = 0; a < 2; ++a)
#pragma unroll
        for (int b = 0; b < 2; ++b)
#pragma unroll
            for (int m = 0; m < 4; ++m)
#pragma unroll
                for (int n = 0; n < 2; ++n) acc[a][b][m][n] = (f32x4){0.f, 0.f, 0.f, 0.f};
    bf16x8 At[4][2], B0[2][2], B1[2][2];
    const char* cA = (const char*)g.A + (size_t)cur.pm * tstep; const char* cB = (const char*)g.Bt + (size_t)cur.pn * tstep;
    S.a_ready(cur);
    if constexpr (SP2) {
        PG8_STAGE(PG8_SB(0, 0), cB, voffB); PG8_STAGE(PG8_SB(0, 1), cB + hstep, voffB); PG8_STAGE(PG8_SA(0, 0), cA, voffA); PG8_STAGE(PG8_SA(0, 1), cA + hstep, voffA);
        if (wr == 1) PG8_BAR;
        PG8_WAIT_V(2); PG8_BAR;
        PG8_STAGE(PG8_SB(1, 0), cB + kstep, voffB); PG8_STAGE(PG8_SA(1, 0), cA + kstep, voffA); PG8_STAGE(PG8_SB(1, 1), cB + hstep + kstep, voffB);
        PG8_WAIT_V(6); PG8_BAR;
    } else {
        PG8_STAGE(PG8_SB(0, 0), cB, voffB); PG8_STAGE(PG8_SA(0, 0), cA, voffA); PG8_STAGE(PG8_SB(0, 1), cB + hstep, voffB); PG8_STAGE(PG8_SA(0, 1), cA + hstep, voffA);
        if (wr == 1) PG8_BAR;
        PG8_WAIT_V(4); PG8_BAR;
        PG8_STAGE(PG8_SB(1, 0), cB + kstep, voffB); PG8_STAGE(PG8_SA(1, 0), cA + kstep, voffA); PG8_STAGE(PG8_SB(1, 1), cB + hstep + kstep, voffB);
        PG8_WAIT_V(6); PG8_BAR;
    }
    for (;;) {
        const bool has_next = S.next(ui + 1, nxt);
        const char* nA = has_next ? (const char*)g.A + (size_t)nxt.pm * tstep : cA; const char* nB = has_next ? (const char*)g.Bt + (size_t)nxt.pn * tstep : cB;
#pragma unroll 1
        for (int t = 0; t < nt; t += 2) {
            const bool last = (t == nt - 2);
            const char* a1 = cA + (size_t)(t + 1) * kstep;
            const char* a2 = last ? nA : cA + (size_t)(t + 2) * kstep; const char* b2 = last ? nB : cB + (size_t)(t + 2) * kstep;
            const char* a3 = a2 + kstep; const char* b3 = b2 + kstep;
            if (last && has_next) S.a_ready(nxt);
            if constexpr (SP2) {
            PG8_LDB(B0, 0, 0); PG8_LDB(B1, 0, 1); PG8_SCHED; PG8_LDA(At, 0, 0); PG8_STAGE(PG8_SA(1, 1), a1 + hstep, voffA);
            PG8_WAIT_V(8); PG8_WAIT_L(0); PG8_BAR; PG8_MMA(0, 0, At, B0); PG8_MMA(0, 1, At, B1); PG8_BAR; PG8_SCHED;
            PG8_LDA(At, 0, 1); PG8_STAGE(PG8_SB(0, 0), b2, voffB); PG8_STAGE(PG8_SB(0, 1), b2 + hstep, voffB); PG8_STAGE(PG8_SA(0, 0), a2, voffA);
            PG8_WAIT_V(8); PG8_WAIT_L(0); PG8_BAR; PG8_MMA(1, 0, At, B0); PG8_MMA(1, 1, At, B1); PG8_BAR; PG8_SCHED;
            PG8_LDB(B0, 1, 0); PG8_LDB(B1, 1, 1); PG8_SCHED; PG8_LDA(At, 1, 0); PG8_STAGE(PG8_SA(0, 1), a2 + hstep, voffA);
            PG8_WAIT_V(8); PG8_WAIT_L(0); PG8_BAR; PG8_MMA(0, 0, At, B0); PG8_MMA(0, 1, At, B1); PG8_BAR; PG8_SCHED;
            PG8_LDA(At, 1, 1); PG8_STAGE(PG8_SB(1, 0), b3, voffB); PG8_STAGE(PG8_SB(1, 1), b3 + hstep, voffB); PG8_STAGE(PG8_SA(1, 0), a3, voffA);
            PG8_WAIT_V(8); PG8_WAIT_L(0); PG8_BAR; PG8_MMA(1, 0, At, B0); PG8_MMA(1, 1, At, B1); PG8_BAR; PG8_SCHED;
            } else {
            PG8_LDB(B0, 0, 0); PG8_SCHED; PG8_LDA(At, 0, 0); PG8_STAGE(PG8_SA(1, 1), a1 + hstep, voffA);
            PG8_WAIT_L(8); PG8_BAR; PG8_WAIT_L(0); PG8_MMA(0, 0, At, B0); PG8_BAR; PG8_SCHED;
            PG8_LDB(B1, 0, 1); PG8_STAGE(PG8_SB(0, 0), b2, voffB);
            PG8_BAR; PG8_WAIT_L(0); PG8_MMA(0, 1, At, B1); PG8_BAR;
            PG8_LDA(At, 0, 1); PG8_STAGE(PG8_SA(0, 0), a2, voffA);
            PG8_BAR; PG8_WAIT_L(0); PG8_MMA(1, 0, At, B0); PG8_BAR; PG8_SCHED;
            PG8_STAGE(PG8_SB(0, 1), b2 + hstep, voffB);
            PG8_WAIT_V(6); PG8_BAR; PG8_MMA(1, 1, At, B1); PG8_BAR;
            PG8_LDB(B0, 1, 0); PG8_SCHED; PG8_LDA(At, 1, 0); PG8_STAGE(PG8_SA(0, 1), a2 + hstep, voffA);
            PG8_WAIT_L(8); PG8_BAR; PG8_WAIT_L(0); PG8_MMA(0, 0, At, B0); PG8_BAR; PG8_SCHED;
            PG8_LDB(B1, 1, 1); PG8_STAGE(PG8_SB(1, 0), b3, voffB);
            PG8_BAR; PG8_WAIT_L(0); PG8_MMA(0, 1, At, B1); PG8_BAR;
            PG8_LDA(At, 1, 1); PG8_STAGE(PG8_SA(1, 0), a3, voffA);
            PG8_BAR; PG8_WAIT_L(0); PG8_MMA(1, 0, At, B0); PG8_BAR; PG8_SCHED;
            PG8_STAGE(PG8_SB(1, 1), b3 + hstep, voffB);
            PG8_WAIT_V(6); PG8_BAR; PG8_MMA(1, 1, At, B1); PG8_BAR;
            }
        }
        if constexpr (ALIGN_EPI) { if (wr == 0) PG8_BAR; }
        E(acc, cur, wr, wc, fr, fq); S.done(cur);
        if (!has_next) break;
#pragma unroll
        for (int a = 0; a < 2; ++a)
#pragma unroll
            for (int b = 0; b < 2; ++b)
#pragma unroll
                for (int m = 0; m < 4; ++m)
#pragma unroll
                    for (int n = 0; n < 2; ++n) acc[a][b][m][n] = (f32x4){0.f, 0.f, 0.f, 0.f};
        cur = nxt; cA = nA; cB = nB; ++ui;
        if constexpr (ALIGN_EPI) { if (wr == 1) PG8_BAR; }
    }
    PG8_WAIT_V(0);
    if constexpr (!ALIGN_EPI) { if (wr == 0) PG8_BAR; }
    PG8_BAR;
#undef PG8_SA
#undef PG8_SB
#undef PG8_STAGE
#undef PG8_LDA
#undef PG8_LDB
#undef PG8_MMA
#undef PG8_WAIT_V
#undef PG8_WAIT_L
#undef PG8_BAR
#undef PG8_SCHED
}
}

#ifndef PG8_SP2
#define PG8_SP2 true
#endif
#ifndef PG8_ALIGN
#define PG8_ALIGN true
#endif

constexpr int NWAVES = 8;
constexpr int N_LAUNCHES = MK_N_LAUNCHES;
constexpr int N_PHASES = 10;
constexpr int D = 1024, NB = 8, SEQ = 2048, MP = NB * SEQ  , NS = 128, MROWS = MP + NS  , MT = 65 * 256  ;
constexpr int WA = 256, WB = 384, WC = 384, INC = 3200, NIN = 13 * 256  , PLED = 256, TW = 2048  ;
constexpr float EPS = 1e-6f;
constexpr int T_VA = 0, T_SZA = 256, T_UB = 512, T_SZB = 896, T_UC = 1280, T_BZ = 1664;
constexpr size_t O_Y = 0, O_POOLP = (size_t)MROWS * D, O_POOLS = O_POOLP + 2 * 8 * 15 * 256, O_CONVP = O_POOLS + 2 * 128 * 15 * 256, O_CONVS = O_CONVP + 2 * 8 * 30 * 384,
                 O_SCP = O_CONVS + 2 * 128 * 30 * 384, O_SCS = O_SCP + 2 * 8 * 2 * 384, O_END = O_SCS + 2 * 128 * 2 * 384;
constexpr size_t MiB = 1u << 20;
constexpr size_t WS_CTL = 0, CTL_ZERO_BYTES = 1 * MiB;
constexpr size_t WS_WIN = 2 * MiB, WIN_STRIDE = 7 * MiB;
constexpr size_t WS_WOUT = 16 * MiB, WS_WG = 20 * MiB, W1K_STRIDE = 2 * MiB;
constexpr size_t WS_WPLE = 24 * MiB, WPLE_STRIDE = MiB / 2;
constexpr size_t WS_SSQ = 25 * MiB;
constexpr size_t WS_PE = 28 * MiB, PE_STRIDE = 9 * MiB;
constexpr size_t WS_XBA = 46 * MiB, WS_XBB = 79 * MiB, WS_Y = 112 * MiB, WS_PLEO = 145 * MiB;
constexpr size_t WS_T = 178 * MiB;
constexpr size_t WS_END = 243 * MiB;
static_assert((size_t)NIN * D * 2 <= WIN_STRIDE && (size_t)MT * 16 * 4 <= 3 * MiB && (size_t)MT * 256 * 2 <= PE_STRIDE && (size_t)MT * D * 2 <= 33 * MiB && (size_t)MT * TW * 2 <= 65 * MiB, "ws map");
constexpr int CW_BAR = 4096;
constexpr int RING_OFF = 0, RING_BYTES = 131072;
constexpr int LDSCTL_OFF = RING_BYTES, MISC_OFF = LDSCTL_OFF + 320;
constexpr int LDS_BYTES = 147456;

#define GAS __attribute__((address_space(1)))
#define LAS __attribute__((address_space(3)))
typedef unsigned short bf16;
typedef unsigned v4u __attribute__((ext_vector_type(4)));
typedef unsigned v2u __attribute__((ext_vector_type(2)));
typedef float f32x4 __attribute__((ext_vector_type(4)));
typedef float f32x2 __attribute__((ext_vector_type(2)));
typedef GAS unsigned gu32;
#define RLX_AGENT __ATOMIC_RELAXED, __HIP_MEMORY_SCOPE_AGENT
#define LDS_WAIT() asm volatile("s_waitcnt lgkmcnt(0)" ::: "memory")
#define VM_WAIT() asm volatile("s_waitcnt vmcnt(0)" ::: "memory")
__device__ __forceinline__ unsigned f2bf(float f) { unsigned u = __builtin_bit_cast(unsigned, f); return (u + 0x7fffu + ((u >> 16) & 1u)) >> 16; }
__device__ __forceinline__ unsigned pk2(float lo, float hi) { return f2bf(lo) | (f2bf(hi) << 16); }
__device__ __forceinline__ float bf_lo(unsigned u) { return __builtin_bit_cast(float, u << 16); }
__device__ __forceinline__ float bf_hi(unsigned u) { return __builtin_bit_cast(float, u & 0xffff0000u); }
__device__ __forceinline__ float sigmoidf_(float x) { return __builtin_amdgcn_rcpf(1.0f + __expf(-x)); }
__device__ __forceinline__ float siluf_(float x) { return x * sigmoidf_(x); }

#define XB_TMO      128
#define XB_XCNT(j)  (256  + 64 * (j))
#define XB_XSUB(j)  (1280 + 64 * (j))
#define XB_XGEN(j)  (2304 + 64 * (j))
#define XB_TOP      3328
#define XB_TOPGEN   3392
#define XCD_BAR_WORDS 3456
#define XB_SPIN_CAP (1u << 18)
__device__ __forceinline__ unsigned xb_ld(unsigned* p)              { return __hip_atomic_load(p, __ATOMIC_RELAXED, __HIP_MEMORY_SCOPE_AGENT); }
__device__ __forceinline__ unsigned xb_add(unsigned* p, unsigned v) { return __hip_atomic_fetch_add(p, v, __ATOMIC_RELAXED, __HIP_MEMORY_SCOPE_AGENT); }
__device__ __forceinline__ unsigned xb_xcc_id() { return (unsigned)__builtin_amdgcn_s_getreg((3 << 11) | 20) & 0xFu; }
#define XB_SPIN(cond, bar) do { unsigned _sp = 0; while (cond) { __builtin_amdgcn_s_sleep(1); \
    if ((++_sp & 255u) == 0u) { if (xb_ld(&(bar)[XB_TMO])) break; if (_sp > XB_SPIN_CAP) { atomicAdd(&(bar)[XB_TMO], 1u); break; } } } } while (0)
struct XcdBarrier { unsigned* bar; unsigned x; volatile LAS unsigned* st; };
__device__ __forceinline__ XcdBarrier xcd_barrier_post(unsigned* bar, volatile LAS unsigned* st) {
    XcdBarrier b; b.bar = bar; b.x = xb_xcc_id(); b.st = st;
    if (threadIdx.x == 0) (void)xb_add(&bar[XB_XCNT(b.x)], 1u);
    return b;
}
__device__ __forceinline__ void xcd_barrier_complete(unsigned* bar, unsigned x, unsigned& nloc, unsigned& nx) {
    const unsigned G = gridDim.x * gridDim.y * gridDim.z;
    unsigned sum, cnt, mine, sp = 0u;
    for (;;) {
        sum = 0u; cnt = 0u; mine = 0u;
#pragma unroll
        for (unsigned j = 0; j < 16; ++j) { const unsigned c = xb_ld(&bar[XB_XCNT(j)]); sum += c; cnt += (c > 0u) ? 1u : 0u; mine = (j == x) ? c : mine; }
        if (sum == G) break;
        __builtin_amdgcn_s_sleep(1);
        if ((++sp & 255u) == 0u) { if (xb_ld(&bar[XB_TMO])) break; if (sp > XB_SPIN_CAP) { atomicAdd(&bar[XB_TMO], 1u); break; } }
    }
    nloc = mine > 0u ? mine : 1u; nx = cnt > 0u ? cnt : 1u;
}
__device__ __forceinline__ void xcd_barrier(const XcdBarrier& b) {
    asm volatile("s_waitcnt vmcnt(0)" ::: "memory");
    __syncthreads();
    if (threadIdx.x == 0) {
        unsigned* bar = b.bar;
        __builtin_amdgcn_s_waitcnt(0);
        unsigned nloc = b.st[0], nx = b.st[1];
        if (nloc == 0u) { xcd_barrier_complete(bar, b.x, nloc, nx); b.st[0] = nloc; b.st[1] = nx; }
        const unsigned old = xb_add(&bar[XB_XSUB(b.x)], 1u);
        const unsigned gen = old / nloc;
        if (old + 1u == (gen + 1u) * nloc) {
            __builtin_amdgcn_fence(__ATOMIC_RELEASE, "agent");
            asm volatile("s_waitcnt vmcnt(0)" ::: "memory");
            const unsigned og = xb_add(&bar[XB_TOP], 1u);
            const unsigned tg = og / nx;
            if (og + 1u == (tg + 1u) * nx) xb_add(&bar[XB_TOPGEN], 1u);
            else XB_SPIN(xb_ld(&bar[XB_TOPGEN]) == tg, bar);
            __builtin_amdgcn_fence(__ATOMIC_ACQUIRE, "agent");
            xb_add(&bar[XB_XGEN(b.x)], 1u);
            asm volatile("s_waitcnt vmcnt(0)" ::: "memory");
        } else {
            XB_SPIN(xb_ld(&bar[XB_XGEN(b.x)]) == gen, bar);
            __builtin_amdgcn_fence(__ATOMIC_ACQUIRE, "agent");
            asm volatile("s_waitcnt vmcnt(0)" ::: "memory");
        }
    }
    __syncthreads();
}

struct Args { const float* in[20]; float* out; unsigned char* ws; int ph_lo, ph_hi, li, pad; };
enum { I_XP = 0, I_XS, I_SPOOL, I_SCONV, I_SSCONV, I_PP, I_PS, I_NORMG, I_WIN, I_WMIX, I_PSCALE, I_CBW, I_CBB, I_LNG, I_LNB, I_SCW, I_WOUT, I_WPLE, I_WGATE, I_FNG };
struct Frame {
    LAS unsigned char* lds;
    volatile LAS unsigned* MISC;
    gu32* ctl;
    int tid, lane, wave;
    int vcu, G;
    float* out;
    unsigned char* ws;
};
__device__ __forceinline__ bf16* ws_bf(const Frame& F, size_t off) { return (bf16*)(F.ws + off); }

__device__ __forceinline__ float wave_sum(float v) {
#pragma unroll
    for (int o = 1; o < 64; o <<= 1) v += __shfl_xor(v, o);
    return v;
}

using pg8::Unit; using pg8::cvt_pk_bf16;
__device__ __forceinline__ v4u pack8(const f32x4 a, const f32x4 b) { v4u w; w.x = cvt_pk_bf16(a[0], a[1]); w.y = cvt_pk_bf16(a[2], a[3]); w.z = cvt_pk_bf16(b[0], b[1]); w.w = cvt_pk_bf16(b[2], b[3]); return w; }
__device__ __forceinline__ f32x4 sig4(const f32x4 v) { return (f32x4){sigmoidf_(v[0]), sigmoidf_(v[1]), sigmoidf_(v[2]), sigmoidf_(v[3])}; }
__device__ __forceinline__ f32x4 silu4(const f32x4 v) { return v * sig4(v); }

__device__ __forceinline__ float* state_ptr(float* out, int layer, int row, int H, int C, size_t offP, size_t offS) {
    if (row < MP) { const int b = row >> 11, t = row & 2047, j = t - (SEQ - H); if (j < 0) return nullptr; return out + offP + ((size_t)(layer * NB + b) * H + j) * C; }
    const int s = row - MP; if (s >= NS) return nullptr; return out + offS + ((size_t)(layer * NS + s) * H + (H - 1)) * C;
}

struct EpiIn {
    static constexpr bool PERM = true, AFTER_DRAIN = false;
    bf16* T; const float* ssq; float* out; int layer;
    __device__ __forceinline__ void operator()(const f32x4 (&acc)[2][2][4][2], const Unit& u, int wr, int wc, int fr, int fq) const {
        const int pn = u.pn, pm = u.pm, cl = wc * 32 + 8 * fq, rowb = pm * 256 + wr * 64 + fr;
        const bool has_state = (pm == 64) || ((pm & 7) == 7);
        int ty, oc0, oc1 = 0, sc0 = 0;
        if (pn < 3) { ty = 0; oc0 = T_UB + 128 * pn; sc0 = 128 * pn; }
        else if (pn < 6) { ty = 1; oc0 = T_UC + 128 * (pn - 3); sc0 = 128 * (pn - 3); }
        else if (pn < 9) { ty = 2; oc0 = T_BZ + 128 * (pn - 6); }
        else if (pn == 9) { ty = 3; oc0 = T_VA; oc1 = T_VA + 128; }
        else if (pn == 10) { ty = 4; oc0 = T_SZA; oc1 = T_SZA + 128; }
        else if (pn == 11) { ty = 4; oc0 = T_SZB; oc1 = T_SZB + 128; }
        else { ty = 5; oc0 = T_SZB + 256; }
#pragma unroll
        for (int ai = 0; ai < 2; ++ai)
#pragma unroll
            for (int m = 0; m < 4; ++m) {
                const int row = rowb + ai * 128 + m * 16;
                const f32x4* sp = (const f32x4*)(ssq + (size_t)row * 16);
                const f32x4 s0 = sp[0], s1 = sp[1], s2 = sp[2], s3 = sp[3];
                const float ss = ((s0[0] + s0[1]) + (s0[2] + s0[3])) + ((s1[0] + s1[1]) + (s1[2] + s1[3])) + ((s2[0] + s2[1]) + (s2[2] + s2[3])) + ((s3[0] + s3[1]) + (s3[2] + s3[3]));
                const float rs = __builtin_amdgcn_rsqf(ss * (1.0f / D) + EPS);
                const f32x4 h0a = acc[ai][0][m][0] * rs, h0b = acc[ai][0][m][1] * rs, h1a = acc[ai][1][m][0] * rs, h1b = acc[ai][1][m][1] * rs;
                bf16* trow = T + (size_t)row * TW + cl;
                if (ty == 0 || ty == 1 || ty == 2) {
                    f32x4 oa, ob;
                    if (ty == 0) { oa = h0a * sig4(h1a); ob = h0b * sig4(h1b); }
                    else if (ty == 1) { oa = h0a * h1a; ob = h0b * h1b; }
                    else { oa = h0a * silu4(h1a); ob = h0b * silu4(h1b); }
                    *(v4u*)(trow + oc0) = pack8(oa, ob);
                    if (has_state && ty != 2) {
                        float* p = (ty == 0) ? state_ptr(out, layer, row, 30, 384, O_CONVP, O_CONVS) : state_ptr(out, layer, row, 2, 384, O_SCP, O_SCS);
                        if (p) { *(f32x4*)(p + sc0 + cl) = oa; *(f32x4*)(p + sc0 + cl + 4) = ob; }
                    }
                } else if (ty == 3) {
                    *(v4u*)(trow + oc0) = pack8(h0a, h0b); *(v4u*)(trow + oc1) = pack8(h1a, h1b);
                    if (has_state) { float* p = state_ptr(out, layer, row, 15, 256, O_POOLP, O_POOLS);
                        if (p) { *(f32x4*)(p + cl) = h0a; *(f32x4*)(p + cl + 4) = h0b; *(f32x4*)(p + 128 + cl) = h1a; *(f32x4*)(p + 128 + cl + 4) = h1b; } }
                } else if (ty == 4) {
                    *(v4u*)(trow + oc0) = pack8(silu4(h0a), silu4(h0b)); *(v4u*)(trow + oc1) = pack8(silu4(h1a), silu4(h1b));
                } else {
                    *(v4u*)(trow + oc0) = pack8(silu4(h0a), silu4(h0b));
                }
            }
    }
};

struct EpiOut {
    static constexpr bool PERM = true, AFTER_DRAIN = false;
    const float* xp; const float* xs; float* xres; bf16* xb; int layer;
    __device__ __forceinline__ void operator()(const f32x4 (&acc)[2][2][4][2], const Unit& u, int wr, int wc, int fr, int fq) const {
        const int cl = u.pn * 256 + wc * 32 + 8 * fq, rowb = u.pm * 256 + wr * 64 + fr;
#pragma unroll
        for (int ai = 0; ai < 2; ++ai)
#pragma unroll
            for (int m = 0; m < 4; ++m) {
                const int row = rowb + ai * 128 + m * 16;
                if (row < MROWS) {
                    const float* rin = (layer == 0) ? (row < MP ? xp + (size_t)row * D : xs + (size_t)(row - MP) * D) : xres + (size_t)row * D;
#pragma unroll
                    for (int bj = 0; bj < 2; ++bj) { const int col = cl + bj * 128;
                        const f32x4 a = *(const f32x4*)(rin + col), b = *(const f32x4*)(rin + col + 4);
                        const f32x4 v0 = acc[ai][bj][m][0] + a, v1 = acc[ai][bj][m][1] + b;
                        float* o = xres + (size_t)row * D + col; *(f32x4*)o = v0; *(f32x4*)(o + 4) = v1;
                        *(v4u*)(xb + (size_t)row * D + col) = pack8(v0, v1); }
                }
            }
    }
};

struct EpiPlain {
    static constexpr bool PERM = true, AFTER_DRAIN = false;
    bf16* O;
    __device__ __forceinline__ void operator()(const f32x4 (&acc)[2][2][4][2], const Unit& u, int wr, int wc, int fr, int fq) const {
        const int cl = u.pn * 256 + wc * 32 + 8 * fq, rowb = u.pm * 256 + wr * 64 + fr;
#pragma unroll
        for (int ai = 0; ai < 2; ++ai)
#pragma unroll
            for (int m = 0; m < 4; ++m) { const int row = rowb + ai * 128 + m * 16;
#pragma unroll
                for (int bj = 0; bj < 2; ++bj) *(v4u*)(O + (size_t)row * D + cl + bj * 128) = pack8(acc[ai][bj][m][0], acc[ai][bj][m][1]); }
    }
};

struct EpiGate {
    static constexpr bool PERM = true, AFTER_DRAIN = false;
    float* xres; const bf16* ple; bf16* xb; float* ssq;
    __device__ __forceinline__ void operator()(const f32x4 (&acc)[2][2][4][2], const Unit& u, int wr, int wc, int fr, int fq) const {
        const int cl = u.pn * 256 + wc * 32 + 8 * fq, rowb = u.pm * 256 + wr * 64 + fr;
#pragma unroll
        for (int ai = 0; ai < 2; ++ai)
#pragma unroll
            for (int m = 0; m < 4; ++m) {
                const int row = rowb + ai * 128 + m * 16;
                const bool valid = row < MROWS;
                float ss = 0.f;
#pragma unroll
                for (int bj = 0; bj < 2; ++bj) { const int col = cl + bj * 128;
                    float* o = xres + (size_t)row * D + col;
                    f32x4 a = (f32x4){0.f, 0.f, 0.f, 0.f}, b = a;
                    if (valid) { a = *(const f32x4*)o; b = *(const f32x4*)(o + 4); }
                    const v4u pw = *(const v4u*)(ple + (size_t)row * D + col);
                    const f32x4 pa = (f32x4){bf_lo(pw.x), bf_hi(pw.x), bf_lo(pw.y), bf_hi(pw.y)}, pb = (f32x4){bf_lo(pw.z), bf_hi(pw.z), bf_lo(pw.w), bf_hi(pw.w)};
                    const f32x4 v0 = a + pa * sig4(acc[ai][bj][m][0]), v1 = b + pb * sig4(acc[ai][bj][m][1]);
                    ss += (v0[0] * v0[0] + v0[1] * v0[1]) + (v0[2] * v0[2] + v0[3] * v0[3]) + (v1[0] * v1[0] + v1[1] * v1[1]) + (v1[2] * v1[2] + v1[3] * v1[3]);
                    if (valid) { *(f32x4*)o = v0; *(f32x4*)(o + 4) = v1; *(v4u*)(xb + (size_t)row * D + col) = pack8(v0, v1); }
                }
                ss += __shfl_xor(ss, 16); ss += __shfl_xor(ss, 32);
                if (fq == 0) ssq[(size_t)row * 16 + u.pn * 4 + wc] = ss;
            }
    }
};

__device__ __forceinline__ int in_half_src(int hh) {
    const int t = hh >> 1, h = hh & 1;
    if (t < 3) return (h ? 896 : 512) + 128 * t;
    if (t < 6) return (h ? 1664 : 2432) + 128 * (t - 3);
    if (t < 9) return (h ? 2816 : 2048) + 128 * (t - 6);
    if (t == 9) return h ? 128 : 0;
    if (t == 10) return h ? 384 : 256;
    if (t == 11) return h ? 1408 : 1280;
    return 1536;
}
__device__ __forceinline__ void p0_transpose_item(const float* W, int K, int N, int src_n0, bf16* WT, int dst_row0, const float* gscale, LAS float* scr, int k0, int lane) {
#pragma unroll 8
    for (int i = 0; i < 32; ++i) { const int kk = 2 * i + (lane >> 5); float w = W[(size_t)(k0 + kk) * N + src_n0 + (lane & 31)]; if (gscale) w *= gscale[k0 + kk]; scr[kk * 33 + (lane & 31)] = w; }
    LDS_WAIT(); asm volatile("" ::: "memory");
    const int c = lane & 7;
#pragma unroll
    for (int j = 0; j < 4; ++j) { const int n = (lane >> 3) + 8 * j; const LAS float* s = scr + (8 * c) * 33 + n;
        v4u o; o.x = pk2(s[0 * 33], s[1 * 33]); o.y = pk2(s[2 * 33], s[3 * 33]); o.z = pk2(s[4 * 33], s[5 * 33]); o.w = pk2(s[6 * 33], s[7 * 33]);
        *(GAS v4u*)(WT + (size_t)(dst_row0 + n) * K + k0 + 8 * c) = o; }
    LDS_WAIT(); asm volatile("" ::: "memory");
}
__device__ __forceinline__ void p0_prologue(Frame& F, const Args& A) {
    LAS float* scr = (LAS float*)(F.lds + RING_OFF + F.wave * 16384);
    const int gw = F.vcu * NWAVES + F.wave, NGW = F.G * NWAVES;
    constexpr int I_IN = 16 * 104, I_SQ = 16 * 32, I_PLE = 4 * 32, I_L = I_IN + 2 * I_SQ + I_PLE, NITEMS = 2 * I_L;
    for (int it = gw; it < NITEMS; it += NGW) {
        const int l = it / I_L; int r = it % I_L;
        if (r < I_IN) { const int kb = r / 104, nb = r % 104; p0_transpose_item(A.in[I_WIN] + (size_t)l * D * INC, D, INC, in_half_src(nb >> 2) + 32 * (nb & 3), ws_bf(F, WS_WIN + l * WIN_STRIDE), 32 * nb, A.in[I_NORMG] + l * D, scr, 64 * kb, F.lane); continue; } r -= I_IN;
        if (r < I_SQ) { const int kb = r / 32, nb = r % 32; p0_transpose_item(A.in[I_WOUT] + (size_t)l * D * D, D, D, 32 * nb, ws_bf(F, WS_WOUT + l * W1K_STRIDE), 32 * nb, nullptr, scr, 64 * kb, F.lane); continue; } r -= I_SQ;
        if (r < I_SQ) { const int kb = r / 32, nb = r % 32; p0_transpose_item(A.in[I_WGATE] + (size_t)l * D * D, D, D, 32 * nb, ws_bf(F, WS_WG + l * W1K_STRIDE), 32 * nb, nullptr, scr, 64 * kb, F.lane); continue; } r -= I_SQ;
        { const int kb = r / 32, nb = r % 32; p0_transpose_item(A.in[I_WPLE] + (size_t)l * PLED * D, PLED, D, 32 * nb, ws_bf(F, WS_WPLE + l * WPLE_STRIDE), 32 * nb, nullptr, scr, 64 * kb, F.lane); }
    }
    bf16* XB = ws_bf(F, WS_XBA); float* SSQ = (float*)(F.ws + WS_SSQ);
    for (int m = gw; m < MROWS; m += NGW) {
        const float* xrow = m < MP ? A.in[I_XP] + (size_t)m * D : A.in[I_XS] + (size_t)(m - MP) * D;
        const GAS f32x4* xr = (const GAS f32x4*)xrow + F.lane;
        f32x4 v[4]; float s = 0.f;
#pragma unroll
        for (int j = 0; j < 4; ++j) { v[j] = xr[64 * j]; s += (v[j].x * v[j].x + v[j].y * v[j].y) + (v[j].z * v[j].z + v[j].w * v[j].w); }
        s = wave_sum(s);
        GAS v2u* o8 = (GAS v2u*)(XB + (size_t)m * D) + F.lane;
#pragma unroll
        for (int j = 0; j < 4; ++j) o8[64 * j] = (v2u){pk2(v[j].x, v[j].y), pk2(v[j].z, v[j].w)};
        if (F.lane < 16) SSQ[(size_t)m * 16 + F.lane] = (F.lane == 0) ? s : 0.f;
    }
    for (int it = gw; it < 2 * MROWS; it += NGW) {
        const int l = it / MROWS, m = it % MROWS;
        const float* prow = m < MP ? A.in[I_PP] + ((size_t)l * MP + m) * PLED : A.in[I_PS] + ((size_t)l * NS + (m - MP)) * PLED;
        const f32x4 v = ((const GAS f32x4*)prow)[F.lane];
        ((GAS v2u*)(ws_bf(F, WS_PE + l * PE_STRIDE) + (size_t)m * PLED))[F.lane] = (v2u){pk2(v.x, v.y), pk2(v.z, v.w)};
    }
    const int gt = F.vcu * (NWAVES * 64) + F.tid, NGT = F.G * NWAVES * 64;
    for (int i = gt; i < 2 * NS * 14 * 64; i += NGT) { const int ls = i / (14 * 64), r = i % (14 * 64);
        ((GAS f32x4*)(F.out + O_POOLS + (size_t)ls * 15 * 256))[r] = ((const GAS f32x4*)(A.in[I_SPOOL] + (size_t)ls * 15 * 256 + 256))[r]; }
    for (int i = gt; i < 2 * NS * 29 * 96; i += NGT) { const int ls = i / (29 * 96), r = i % (29 * 96);
        ((GAS f32x4*)(F.out + O_CONVS + (size_t)ls * 30 * 384))[r] = ((const GAS f32x4*)(A.in[I_SCONV] + (size_t)ls * 30 * 384 + 384))[r]; }
    for (int i = gt; i < 2 * NS * 96; i += NGT) { const int ls = i / 96, r = i % 96;
        ((GAS f32x4*)(F.out + O_SCS + (size_t)ls * 2 * 384))[r] = ((const GAS f32x4*)(A.in[I_SSCONV] + (size_t)ls * 2 * 384 + 384))[r]; }
}

__device__ __forceinline__ int opaque0() { int z; asm volatile("s_mov_b32 %0, 0" : "=s"(z)); return z; }
__device__ __forceinline__ f32x2 ldbf2(const bf16* p) { const unsigned u = *(const GAS unsigned*)p; return (f32x2){bf_lo(u), bf_hi(u)}; }
__device__ __forceinline__ void mixer_phase(Frame& F, const Args& A, int layer) {
    LAS float* WM = (LAS float*)(F.lds + RING_OFF);
    LAS float* CB = WM + 16384;
    LAS float* PL = CB + 6144;
    LAS unsigned* UBS = (LAS unsigned*)PL;
    const bf16* T = ws_bf(F, WS_T); bf16* Y = ws_bf(F, WS_Y);
    const int tid = F.tid, lane = F.lane, wave = F.wave;
    { const GAS f32x4* wm = (const GAS f32x4*)(A.in[I_WMIX] + (size_t)layer * 16384);
      for (int i = tid; i < 4096; i += 512) ((LAS f32x4*)WM)[i] = wm[i]; }
    const float* cw = A.in[I_CBW] + layer * 31 * WB; const float* cbias = A.in[I_CBB] + layer * WB; const float* lg = A.in[I_LNG] + layer * WB; const float* lb = A.in[I_LNB] + layer * WB;
    const float* sw = A.in[I_SCW] + layer * 3 * WC; const float* psc = A.in[I_PSCALE] + layer * WA;
    for (int u = blockIdx.x; u < 1032; u += gridDim.x) {
        __syncthreads();
        const bool smp = u >= 1024;
        const int row0 = smp ? MP + (u - 1024) * 16 : u * 16;
        const int t0 = smp ? 0 : (row0 & 2047);
        if (!smp) {
            for (int c = tid + opaque0(); c < 46 * 48; c += 512) { const int j = c / 48, cc = c % 48, tt = t0 - 30 + j;
                v4u v = (v4u){0u, 0u, 0u, 0u};
                if (tt >= 0) v = *(const GAS v4u*)(T + (size_t)(row0 - 30 + j) * TW + T_UB + cc * 8);
                *(LAS v4u*)(UBS + j * 192 + cc * 4) = v; }
            __syncthreads();
        }
        if (tid < 384) {
            const int tz = tid + opaque0(), cp = tz % 192, tb = tz / 192, ch = 2 * cp;
            const f32x2 bias = *(const GAS f32x2*)(cbias + ch);
            if (!smp) {
                const LAS unsigned* ub = UBS + (8 * tb) * 192 + cp;
                f32x2 in[38];
#pragma unroll
                for (int j = 0; j < 38; ++j) { const unsigned w = ub[j * 192]; in[j] = (f32x2){bf_lo(w), bf_hi(w)}; }
                f32x2 a[8];
#pragma unroll
                for (int i = 0; i < 8; ++i) a[i] = bias;
#pragma unroll
                for (int k = 0; k < 31; ++k) { const f32x2 w = *(const GAS f32x2*)(cw + k * WB + ch);
#pragma unroll
                    for (int i = 0; i < 8; ++i) a[i] += w * in[i + k]; }
#pragma unroll
                for (int i = 0; i < 8; ++i) *(LAS f32x2*)(CB + (8 * tb + i) * WB + ch) = a[i];
            } else {
#pragma unroll 1
                for (int i = 0; i < 8; ++i) { const int s = (u - 1024) * 16 + 8 * tb + i;
                    const float* st = A.in[I_SCONV] + ((size_t)(layer * NS + s) * 30) * WB + ch;
                    f32x2 a = bias;
#pragma unroll 6
                    for (int k = 0; k < 30; ++k) a += *(const GAS f32x2*)(cw + k * WB + ch) * *(const GAS f32x2*)(st + k * WB);
                    a += *(const GAS f32x2*)(cw + 30 * WB + ch) * ldbf2(T + (size_t)(MP + s) * TW + T_UB + ch);
                    *(LAS f32x2*)(CB + (8 * tb + i) * WB + ch) = a; }
            }
        }
        __syncthreads();
        const int lz = lane + opaque0();
#pragma unroll
        for (int q = 0; q < 2; ++q) { const int tk = 2 * wave + q, row = row0 + tk;
            f32x2 x[3]; float s = 0.f;
#pragma unroll
            for (int j = 0; j < 3; ++j) { x[j] = *(LAS f32x2*)(CB + tk * WB + 128 * j + 2 * lz); s += x[j].x + x[j].y; }
            const float mean = wave_sum(s) * (1.0f / WB); float s2 = 0.f;
#pragma unroll
            for (int j = 0; j < 3; ++j) { x[j] = x[j] - mean; s2 += x[j].x * x[j].x + x[j].y * x[j].y; }
            const float rstd = __builtin_amdgcn_rsqf(wave_sum(s2) * (1.0f / WB) + EPS);
#pragma unroll
            for (int j = 0; j < 3; ++j) { const int ch = 128 * j + 2 * lz;
                const f32x2 g = *(const GAS f32x2*)(lg + ch), b = *(const GAS f32x2*)(lb + ch), z = ldbf2(T + (size_t)row * TW + T_SZB + ch);
                const f32x2 y = x[j] * rstd * g + b;
                *(GAS unsigned*)(Y + (size_t)row * D + WA + ch) = pk2(siluf_(y.x) * z.x, siluf_(y.y) * z.y); }
        }
        const int tzc = tid + opaque0();
#pragma unroll 1
        for (int q = 0; q < 4; ++q) { const int task = tzc + 512 * q, tk = task >> 7, cp = task & 127, ch = 2 * cp, w = 2 << (cp >> 5), row = row0 + tk;
            const f32x2 v = ldbf2(T + (size_t)row * TW + T_VA + ch); f32x2 s = v; float cnt;
            if (!smp) { const int t = t0 + tk; for (int j = 1; j < w; ++j) if (t - j >= 0) s += ldbf2(T + (size_t)(row - j) * TW + T_VA + ch); cnt = (float)(w < t + 1 ? w : t + 1); }
            else { const float* st = A.in[I_SPOOL] + ((size_t)(layer * NS + (row - MP)) * 15) * WA + ch; for (int j = 1; j < w; ++j) s += *(const GAS f32x2*)(st + (15 - j) * WA); cnt = (float)w; }
            *(LAS f32x2*)(PL + tk * WA + ch) = s * (1.0f / cnt) - v; }
        __syncthreads();
        { const int tzd = tid + opaque0(), gd = tzd & 255, g = gd >> 6, d = gd & 63, th = tzd >> 8;
          float a[8];
#pragma unroll
          for (int i = 0; i < 8; ++i) a[i] = 0.f;
          for (int c4 = 0; c4 < 16; ++c4) {
              float wv[4];
#pragma unroll
              for (int i = 0; i < 4; ++i) wv[i] = WM[(g * 64 + 4 * c4 + i) * 64 + d];
#pragma unroll
              for (int i = 0; i < 8; ++i) { const f32x4 p = *(LAS f32x4*)(PL + (8 * th + i) * WA + g * 64 + 4 * c4); a[i] += (p.x * wv[0] + p.y * wv[1]) + (p.z * wv[2] + p.w * wv[3]); }
          }
          const float sc = psc[gd];
#pragma unroll
          for (int i = 0; i < 8; ++i) { const int row = row0 + 8 * th + i; const float z = bf_lo((unsigned)T[(size_t)row * TW + T_SZA + gd]); Y[(size_t)row * D + gd] = (bf16)f2bf(a[i] * sc * z); }
        }
        const int tze = tid + opaque0();
#pragma unroll 2
        for (int q = 0; q < 6; ++q) { const int task = tze + 512 * q, tk = task / 192, cp = task % 192, ch = 2 * cp, row = row0 + tk;
            const f32x2 u0 = ldbf2(T + (size_t)row * TW + T_UC + ch); f32x2 u1, u2;
            if (!smp) { const int t = t0 + tk; u1 = t >= 1 ? ldbf2(T + (size_t)(row - 1) * TW + T_UC + ch) : (f32x2){0.f, 0.f}; u2 = t >= 2 ? ldbf2(T + (size_t)(row - 2) * TW + T_UC + ch) : (f32x2){0.f, 0.f}; }
            else { const float* st = A.in[I_SSCONV] + ((size_t)(layer * NS + (row - MP)) * 2) * WC + ch; u1 = *(const GAS f32x2*)(st + WC); u2 = *(const GAS f32x2*)st; }
            const f32x2 s = *(const GAS f32x2*)(sw + ch) * u2 + *(const GAS f32x2*)(sw + WC + ch) * u1 + *(const GAS f32x2*)(sw + 2 * WC + ch) * u0;
            const f32x2 bz = ldbf2(T + (size_t)row * TW + T_BZ + ch);
            *(GAS unsigned*)(Y + (size_t)row * D + WA + WB + ch) = pk2(s.x * bz.x, s.y * bz.y); }
    }
    __syncthreads();
}

__device__ __forceinline__ void final_norm_phase(Frame& F, const Args& A) {
    const int gw = F.vcu * NWAVES + F.wave, NGW = F.G * NWAVES;
    const float* SSQ = (const float*)(F.ws + WS_SSQ);
    f32x4 g[4];
#pragma unroll
    for (int j = 0; j < 4; ++j) g[j] = ((const GAS f32x4*)A.in[I_FNG])[F.lane + 64 * j];
    for (int m = gw; m < MROWS; m += NGW) {
        float s = (F.lane < 16) ? SSQ[(size_t)m * 16 + F.lane] : 0.f;
        s = wave_sum(s);
        const float rs = __builtin_amdgcn_rsqf(s * (1.0f / D) + EPS);
        GAS f32x4* xr = (GAS f32x4*)(F.out + (size_t)m * D) + F.lane;
#pragma unroll
        for (int j = 0; j < 4; ++j) { const f32x4 v = xr[64 * j]; xr[64 * j] = v * rs * g[j]; }
    }
}

__global__ void __launch_bounds__(NWAVES * 64, 2) mk_fwd(Args args) {
    extern __shared__ __attribute__((aligned(16))) unsigned char lds[];
    Frame F;
    F.lds = (LAS unsigned char*)lds;
    F.MISC = (volatile LAS unsigned*)(F.lds + MISC_OFF);
    F.tid = threadIdx.x; F.lane = F.tid & 63; F.wave = __builtin_amdgcn_readfirstlane(F.tid >> 6);
    F.G = gridDim.x; { const int bx = blockIdx.x; F.vcu = (F.G % 8 == 0) ? (bx % 8) * (F.G / 8) + bx / 8 : bx; }
    F.ws = args.ws; F.out = args.out;
    F.ctl = (gu32*)(args.ws + WS_CTL);
    for (int u = F.tid; u < (LDS_BYTES - LDSCTL_OFF) / 4; u += NWAVES * 64) ((LAS unsigned*)(F.lds + LDSCTL_OFF))[u] = 0u;
    __syncthreads();
    XcdBarrier bar; bar.bar = (unsigned*)(F.ctl + CW_BAR); bar.x = 0; bar.st = nullptr;
    if (N_LAUNCHES == 1) bar = xcd_barrier_post((unsigned*)(F.ctl + CW_BAR), F.MISC + 8);
#define GRID_BAR() do { if (N_LAUNCHES == 1) xcd_barrier(bar); } while (0)
    const int lo = args.ph_lo, hi = args.ph_hi;
#define IN(k) (lo <= (k) && (k) < hi)
#define BOTH(k) (IN(k) && IN((k) + 1))
    float* SSQ = (float*)(F.ws + WS_SSQ);
    if (IN(0)) {
#ifndef SKIP_P0
        p0_prologue(F, args);
#endif
        if (BOTH(0)) GRID_BAR(); }
#pragma unroll 1
    for (int l = 0; l < 2; ++l) {
        const int pb = 1 + 4 * l;
        bf16* XBA = ws_bf(F, WS_XBA); bf16* XBB = ws_bf(F, WS_XBB);
        if (IN(pb)) {
            pg8::Gemm g{XBA, ws_bf(F, WS_WIN + l * WIN_STRIDE), MT, NIN, D}; pg8::StaticOrder S; S.init(MT, NIN, F.G, (int)blockIdx.x);
            EpiIn E{ws_bf(F, WS_T), SSQ, F.out, l};
#ifndef SKIP_GIN
            pg8::gemm_phase<EpiIn, pg8::StaticOrder, PG8_ALIGN, PG8_SP2>(F.lds + RING_OFF, g, S, E);
#endif
            if (BOTH(pb)) GRID_BAR();
        }
        if (IN(pb + 1)) {
#ifndef SKIP_MIX
            mixer_phase(F, args, l);
#endif
            if (BOTH(pb + 1)) GRID_BAR(); }
        if (IN(pb + 2)) {
            { pg8::Gemm g{ws_bf(F, WS_Y), ws_bf(F, WS_WOUT + l * W1K_STRIDE), MT, D, D}; pg8::StaticOrder S; S.init(MT, D, F.G, (int)blockIdx.x);
              EpiOut E{args.in[I_XP], args.in[I_XS], F.out, XBB, l};
#ifndef SKIP_GOUT
              pg8::gemm_phase<EpiOut, pg8::StaticOrder, PG8_ALIGN, PG8_SP2>(F.lds + RING_OFF, g, S, E);
#endif
            }
            { pg8::Gemm g{ws_bf(F, WS_PE + l * PE_STRIDE), ws_bf(F, WS_WPLE + l * WPLE_STRIDE), MT, D, PLED}; pg8::StaticOrder S; S.init(MT, D, F.G, (int)blockIdx.x);
              EpiPlain E{ws_bf(F, WS_PLEO)};
#ifndef SKIP_GPLE
              pg8::gemm_phase<EpiPlain, pg8::StaticOrder, PG8_ALIGN, PG8_SP2>(F.lds + RING_OFF, g, S, E);
#endif
            }
            if (BOTH(pb + 2)) GRID_BAR();
        }
        if (IN(pb + 3)) {
            pg8::Gemm g{XBB, ws_bf(F, WS_WG + l * W1K_STRIDE), MT, D, D}; pg8::StaticOrder S; S.init(MT, D, F.G, (int)blockIdx.x);
            EpiGate E{F.out, ws_bf(F, WS_PLEO), XBA, SSQ};
#ifndef SKIP_GGATE
            pg8::gemm_phase<EpiGate, pg8::StaticOrder, PG8_ALIGN, PG8_SP2>(F.lds + RING_OFF, g, S, E);
#endif
            if (BOTH(pb + 3)) GRID_BAR();
        }
    }
#ifndef SKIP_FN
    if (IN(9)) final_norm_phase(F, args);
#endif
#undef IN
#undef BOTH
}

extern "C" void kernel_launch(void* const* d_in, const int* in_sizes, int n_in, void* d_out, int out_size, void* d_ws, size_t ws_size, hipStream_t stream) {
    static int grid = 0;
    if (grid == 0) {
        if (n_in != 20 || out_size != (int)O_END || ws_size < WS_END) { fprintf(stderr, "kernel_launch: unexpected shapes: n_in %d out %d ws %zu\n", n_in, out_size, ws_size); grid = -1; return; }
        int dev = 0, cus = 0, per_cu = 0;
        if (hipGetDevice(&dev) != hipSuccess || hipDeviceGetAttribute(&cus, hipDeviceAttributeMultiprocessorCount, dev) != hipSuccess) { grid = -1; return; }
        if (hipFuncSetAttribute((const void*)mk_fwd, hipFuncAttributeMaxDynamicSharedMemorySize, LDS_BYTES) != hipSuccess) { fprintf(stderr, "kernel_launch: hipFuncSetAttribute failed\n"); grid = -1; return; }
        if (hipOccupancyMaxActiveBlocksPerMultiprocessor(&per_cu, (const void*)mk_fwd, NWAVES * 64, LDS_BYTES) != hipSuccess || per_cu < 1)
            fprintf(stderr, "kernel_launch: occupancy query reports %d workgroups per CU\n", per_cu);
        (void)hipGetLastError();
        grid = cus;
    }
    if (grid < 0) return;
    (void)hipMemsetAsync((char*)d_ws + WS_CTL, 0, CTL_ZERO_BYTES, stream);
    Args a{};
    for (int i = 0; i < 20; ++i) a.in[i] = (const float*)d_in[i];
    a.out = (float*)d_out; a.ws = (unsigned char*)d_ws;
    if (N_LAUNCHES == 1) { a.ph_lo = 0; a.ph_hi = N_PHASES; a.li = 0; hipLaunchKernelGGL(mk_fwd, dim3(grid), dim3(NWAVES * 64), LDS_BYTES, stream, a); }
    else for (int li = 0; li < N_PHASES; ++li) { a.ph_lo = li; a.ph_hi = li + 1; a.li = li; hipLaunchKernelGGL(mk_fwd, dim3(grid), dim3(NWAVES * 64), LDS_BYTES, stream, a); }
}
```

```cpp
#include <hip/hip_runtime.h>
#include <cstdio>
#include <cstdint>

#ifndef MK_N_LAUNCHES
#define MK_N_LAUNCHES 1
#endif

namespace pg8 {
#define PG8_LAS __attribute__((address_space(3)))
typedef unsigned short bf16_t;
typedef short bf16x8 __attribute__((ext_vector_type(8)));
typedef float f32x4 __attribute__((ext_vector_type(4)));
typedef unsigned u32x4 __attribute__((ext_vector_type(4)));
typedef unsigned u32x2 __attribute__((ext_vector_type(2)));
constexpr int BM = 256, BK = 64, HALF = 128, HTB = HALF * BK * 2  , STAGE_BYTES = 8 * HTB, NXCD = 8, WGM = 8;

__host__ __device__ __forceinline__ int lds_byte(int r, int c) { const int st = (r >> 4) * 2 + (c >> 5), rr = r & 15, cc = c & 31, ob = rr * 64 + cc * 2; return st * 1024 + (ob ^ (((ob >> 9) & 1) << 5)); }
__host__ __device__ __forceinline__ void stage_rc(int b, int& R, int& C) { const int st = b / 1024, sb = b % 1024, swz = sb ^ (((sb >> 9) & 1) << 5); R = (st >> 1) * 16 + swz / 64; C = (st & 1) * 32 + (swz % 64) / 2; }
__host__ __device__ __forceinline__ int perm32(int rho) { const int n = rho >> 4, i = rho & 15; return 8 * (i >> 2) + 4 * n + (i & 3); }

struct Unit { int pm, pn; };
struct Gemm { const bf16_t* A; const bf16_t* Bt; int M, N, K; };

struct StaticOrder {
    int nM, nN, nwg, G, c;
    __host__ __device__ void init(int M, int N, int G_, int c_) { nM = M / BM; nN = N / BM; nwg = nM * nN; G = G_; c = c_; }
    __host__ __device__ bool next(int i, Unit& u) const {
        const long L = (long)i * G + c; if (L >= nwg) return false;
        int wgid = (int)L; { const int q = nwg / NXCD, r = nwg % NXCD, xcd = wgid % NXCD, off = wgid / NXCD; wgid = (xcd < r ? xcd * (q + 1) : r * (q + 1) + (xcd - r) * q) + off; }
        const int nig = WGM * nN, gid = wgid / nig, fm = gid * WGM, gsz = (nM - fm) < WGM ? (nM - fm) : WGM;
        u.pm = fm + ((wgid % nig) % gsz); u.pn = (wgid % nig) / gsz; return true;
    }
    __device__ __forceinline__ void a_ready(const Unit&) const {}
    __device__ __forceinline__ void done(const Unit&) const {}
};

__device__ __forceinline__ unsigned cvt_pk_bf16(float lo, float hi) { unsigned r; asm volatile("v_cvt_pk_bf16_f32 %0, %1, %2" : "=v"(r) : "v"(lo), "v"(hi)); return r; }

template <class Epi, class Sched, bool ALIGN_EPI = false, bool SP2 = false>
__device__ __forceinline__ void gemm_phase(PG8_LAS unsigned char* lds, const Gemm g, const Sched& S, const Epi& E) {
    int tz0; asm volatile("s_mov_b32 %0, 0" : "=s"(tz0));
    const int tid = threadIdx.x + tz0, wid = __builtin_amdgcn_readfirstlane(tid >> 6), lane = tid & 63, wr = wid >> 2, wc = wid & 3, fr = lane & 15, fq = lane >> 4;
    const int K = g.K, nt = K / BK;
    unsigned voffA[2], voffB[2];
#pragma unroll
    for (int i = 0; i < 2; ++i) { int R, C; stage_rc(tid * 16 + i * 8192, R, C); const int Rb = Epi::PERM ? ((R & ~31) + perm32(R & 31)) : R;
        voffA[i] = (unsigned)(R * K + C) * 2u; voffB[i] = (unsigned)(Rb * K + C) * 2u; }
    const size_t kstep = (size_t)(BK * 2);
    const size_t hstep = (size_t)HALF * K * 2;
    const size_t tstep = 2 * hstep;
    const unsigned ldsw = (unsigned)wid * 1024u;
    const int aoff = lds_byte(wr * 64 + fr, fq * 8), boff = lds_byte(wc * 32 + fr, fq * 8);
#define PG8_SA(b, h) (((b) * 2 + (h)) * HTB)
#define PG8_SB(b, h) ((4 + (b) * 2 + (h)) * HTB)
#define PG8_STAGE(bufoff, gbase, voff) do { _Pragma("unroll") for (int _i = 0; _i < 2; ++_i) \
        __builtin_amdgcn_global_load_lds((const unsigned*)((const char*)(gbase) + (voff)[_i]), (PG8_LAS unsigned*)(lds + (bufoff) + ldsw + _i * 8192), 16, 0, 0); } while (0)
#define PG8_LDA(dst, b, h) do { _Pragma("unroll") for (int m = 0; m < 4; ++m) _Pragma("unroll") for (int k = 0; k < 2; ++k) dst[m][k] = *(const PG8_LAS bf16x8*)(lds + PG8_SA(b, h) + aoff + m * 2048 + k * 1024); } while (0)
#define PG8_LDB(dst, b, h) do { _Pragma("unroll") for (int n = 0; n < 2; ++n) _Pragma("unroll") for (int k = 0; k < 2; ++k) dst[n][k] = *(const PG8_LAS bf16x8*)(lds + PG8_SB(b, h) + boff + n * 2048 + k * 1024); } while (0)
#define PG8_MMA(ai, bj, At, Bt) do { __builtin_amdgcn_s_setprio(1); _Pragma("unroll") for (int m = 0; m < 4; ++m) _Pragma("unroll") for (int n = 0; n < 2; ++n) _Pragma("unroll") for (int k = 0; k < 2; ++k) \
        acc[ai][bj][m][n] = __builtin_amdgcn_mfma_f32_16x16x32_bf16(Bt[n][k], At[m][k], acc[ai][bj][m][n], 0, 0, 0); __builtin_amdgcn_s_setprio(0); } while (0)
#define PG8_WAIT_V(n) asm volatile("s_waitcnt vmcnt(" #n ")" ::: "memory")
#define PG8_WAIT_L(n) asm volatile("s_waitcnt lgkmcnt(" #n ")" ::: "memory")
#define PG8_BAR __builtin_amdgcn_s_barrier()
#define PG8_SCHED __builtin_amdgcn_sched_barrier(0)
    Unit cur, nxt; int ui = 0;
    if (!S.next(0, cur)) return;
    f32x4 acc[2][2][4][2];
#pragma unroll
    for (int a = 0; a < 2; ++a)
#pragma unroll
        for (int b = 0; b < 2; ++b)
#pragma unroll
            for (int m = 0; m < 4; ++m)
#pragma unroll
                for (int n = 0; n < 2; ++n) acc[a][b][m][n] = (f32x4){0.f, 0.f, 0.f, 0.f};
    bf16x8 At[4][2], B0[2][2], B1[2][2];
    const char* cA = (const char*)g.A + (size_t)cur.pm * tstep; const char* cB = (const char*)g.Bt + (size_t)cur.pn * tstep;
    S.a_ready(cur);
    if constexpr (SP2) {
        PG8_STAGE(PG8_SB(0, 0), cB, voffB); PG8_STAGE(PG8_SB(0, 1), cB + hstep, voffB); PG8_STAGE(PG8_SA(0, 0), cA, voffA); PG8_STAGE(PG8_SA(0, 1), cA + hstep, voffA);
        if (wr == 1) PG8_BAR;
        PG8_WAIT_V(2); PG8_BAR;
        PG8_STAGE(PG8_SB(1, 0), cB + kstep, voffB); PG8_STAGE(PG8_SA(1, 0), cA + kstep, voffA); PG8_STAGE(PG8_SB(1, 1), cB + hstep + kstep, voffB);
        PG8_WAIT_V(6); PG8_BAR;
    } else {
        PG8_STAGE(PG8_SB(0, 0), cB, voffB); PG8_STAGE(PG8_SA(0, 0), cA, voffA); PG8_STAGE(PG8_SB(0, 1), cB + hstep, voffB); PG8_STAGE(PG8_SA(0, 1), cA + hstep, voffA);
        if (wr == 1) PG8_BAR;
        PG8_WAIT_V(4); PG8_BAR;
        PG8_STAGE(PG8_SB(1, 0), cB + kstep, voffB); PG8_STAGE(PG8_SA(1, 0), cA + kstep, voffA); PG8_STAGE(PG8_SB(1, 1), cB + hstep + kstep, voffB);
        PG8_WAIT_V(6); PG8_BAR;
    }
    for (;;) {
        const bool has_next = S.next(ui + 1, nxt);
        const char* nA = has_next ? (const char*)g.A + (size_t)nxt.pm * tstep : cA; const char* nB = has_next ? (const char*)g.Bt + (size_t)nxt.pn * tstep : cB;
#pragma unroll 1
        for (int t = 0; t < nt; t += 2) {
            const bool last = (t == nt - 2);
            const char* a1 = cA + (size_t)(t + 1) * kstep;
            const char* a2 = last ? nA : cA + (size_t)(t + 2) * kstep; const char* b2 = last ? nB : cB + (size_t)(t + 2) * kstep;
            const char* a3 = a2 + kstep; const char* b3 = b2 + kstep;
            if (last && has_next) S.a_ready(nxt);
            if constexpr (SP2) {
            PG8_LDB(B0, 0, 0); PG8_LDB(B1, 0, 1); PG8_SCHED; PG8_LDA(At, 0, 0); PG8_STAGE(PG8_SA(1, 1), a1 + hstep, voffA);
            PG8_WAIT_V(8); PG8_WAIT_L(0); PG8_BAR; PG8_MMA(0, 0, At, B0); PG8_MMA(0, 1, At, B1); PG8_BAR; PG8_SCHED;
            PG8_LDA(At, 0, 1); PG8_STAGE(PG8_SB(0, 0), b2, voffB); PG8_STAGE(PG8_SB(0, 1), b2 + hstep, voffB); PG8_STAGE(PG8_SA(0, 0), a2, voffA);
            PG8_WAIT_V(8); PG8_WAIT_L(0); PG8_BAR; PG8_MMA(1, 0, At, B0); PG8_MMA(1, 1, At, B1); PG8_BAR; PG8_SCHED;
            PG8_LDB(B0, 1, 0); PG8_LDB(B1, 1, 1); PG8_SCHED; PG8_LDA(At, 1, 0); PG8_STAGE(PG8_SA(0, 1), a2 + hstep, voffA);
            PG8_WAIT_V(8); PG8_WAIT_L(0); PG8_BAR; PG8_MMA(0, 0, At, B0); PG8_MMA(0, 1, At, B1); PG8_BAR; PG8_SCHED;
            PG8_LDA(At, 1, 1); PG8_STAGE(PG8_SB(1, 0), b3, voffB); PG8_STAGE(PG8_SB(1, 1), b3 + hstep, voffB); PG8_STAGE(PG8_SA(1, 0), a3, voffA);
            PG8_WAIT_V(8); PG8_WAIT_L(0); PG8_BAR; PG8_MMA(1, 0, At, B0); PG8_MMA(1, 1, At, B1); PG8_BAR; PG8_SCHED;
            } else {
            PG8_LDB(B0, 0, 0); PG8_SCHED; PG8_LDA(At, 0, 0); PG8_STAGE(PG8_SA(1, 1), a1 + hstep, voffA);
            PG8_WAIT_L(8); PG8_BAR; PG8_WAIT_L(0); PG8_MMA(0, 0, At, B0); PG8_BAR; PG8_SCHED;
            PG8_LDB(B1, 0, 1); PG8_STAGE(PG8_SB(0, 0), b2, voffB);
            PG8_BAR; PG8_WAIT_L(0); PG8_MMA(0, 1, At, B1); PG8_BAR;
            PG8_LDA(At, 0, 1); PG8_STAGE(PG8_SA(0, 0), a2, voffA);
            PG8_BAR; PG8_WAIT_L(0); PG8_MMA(1, 0, At, B0); PG8_BAR; PG8_SCHED;
            PG8_STAGE(PG8_SB(0, 1), b2 + hstep, voffB);
            PG8_WAIT_V(6); PG8_BAR; PG8_MMA(1, 1, At, B1); PG8_BAR;
            PG8_LDB(B0, 1, 0); PG8_SCHED; PG8_LDA(At, 1, 0); PG8_STAGE(PG8_SA(0, 1), a2 + hstep, voffA);
            PG8_WAIT_L(8); PG8_BAR; PG8_WAIT_L(0); PG8_MMA(0, 0, At, B0); PG8_BAR; PG8_SCHED;
            PG8_LDB(B1, 1, 1); PG8_STAGE(PG8_SB(1, 0), b3, voffB);
            PG8_BAR; PG8_WAIT_L(0); PG8_MMA(0, 1, At, B1); PG8_BAR;
            PG8_LDA(At, 1, 1); PG8_STAGE(PG8_SA(1, 0), a3, voffA);
            PG8_BAR; PG8_WAIT_L(0); PG8_MMA(1, 0, At, B0); PG8_BAR; PG8_SCHED;
            PG8_STAGE(PG8_SB(1, 1), b3 + hstep, voffB);
            PG8_WAIT_V(6); PG8_BAR; PG8_MMA(1, 1, At, B1); PG8_BAR;
            }
        }
        if constexpr (ALIGN_EPI) { if (wr == 0) PG8_BAR; }
        E(acc, cur, wr, wc, fr, fq); S.done(cur);
        if (!has_next) break;
#pragma unroll
        for (int a = 0; a < 2; ++a)
#pragma unroll
            for (int b = 0; b < 2; ++b)
#pragma unroll
                for (int m = 0; m < 4; ++m)
#pragma unroll
                    for (int n = 0; n < 2; ++n) acc[a][b][m][n] = (f32x4){0.f, 0.f, 0.f, 0.f};
        cur = nxt; cA = nA; cB = nB; ++ui;
        if constexpr (ALIGN_EPI) { if (wr == 1) PG8_BAR; }
    }
    PG8_WAIT_V(0);
    if constexpr (!ALIGN_EPI) { if (wr == 0) PG8_BAR; }
    PG8_BAR;
#undef PG8_SA
#undef PG8_SB
#undef PG8_STAGE
#undef PG8_LDA
#undef PG8_LDB
#undef PG8_MMA
#undef PG8_WAIT_V
#undef PG8_WAIT_L
#undef PG8_BAR
#undef PG8_SCHED
}
}

#ifndef PG8_SP2
#define PG8_SP2 true
#endif
#ifndef PG8_ALIGN
#define PG8_ALIGN true
#endif

constexpr int NWAVES = 8;
constexpr int N_LAUNCHES = MK_N_LAUNCHES;
constexpr int N_PHASES = 10;
constexpr int D = 1024, NB = 8, SEQ = 2048, MP = NB * SEQ  , NS = 128, MROWS = MP + NS  , MT = 65 * 256  ;
constexpr int WA = 256, WB = 384, WC = 384, INC = 3200, NIN = 13 * 256  , PLED = 256, TW = 2048  ;
constexpr float EPS = 1e-6f;
constexpr int T_VA = 0, T_SZA = 256, T_UB = 512, T_SZB = 896, T_UC = 1280, T_BZ = 1664;
constexpr size_t O_Y = 0, O_POOLP = (size_t)MROWS * D, O_POOLS = O_POOLP + 2 * 8 * 15 * 256, O_CONVP = O_POOLS + 2 * 128 * 15 * 256, O_CONVS = O_CONVP + 2 * 8 * 30 * 384,
                 O_SCP = O_CONVS + 2 * 128 * 30 * 384, O_SCS = O_SCP + 2 * 8 * 2 * 384, O_END = O_SCS + 2 * 128 * 2 * 384;
constexpr size_t MiB = 1u << 20;
constexpr size_t WS_CTL = 0, CTL_ZERO_BYTES = 1 * MiB;
constexpr size_t WS_WIN = 2 * MiB, WIN_STRIDE = 7 * MiB;
constexpr size_t WS_WOUT = 16 * MiB, WS_WG = 20 * MiB, W1K_STRIDE = 2 * MiB;
constexpr size_t WS_WPLE = 24 * MiB, WPLE_STRIDE = MiB / 2;
constexpr size_t WS_SSQ = 25 * MiB;
constexpr size_t WS_PSB = 27 * MiB, WS_PSA = WS_PSB + 2 * 128 * 384 * 4, WS_PSC = WS_PSA + 2 * 128 * 256 * 4;
constexpr size_t WS_PE = 28 * MiB, PE_STRIDE = 9 * MiB;
constexpr size_t WS_XBA = 46 * MiB, WS_XBB = 79 * MiB, WS_Y = 112 * MiB, WS_PLEO = 145 * MiB;
constexpr size_t WS_T = 178 * MiB;
constexpr size_t WS_END = 243 * MiB;
static_assert((size_t)NIN * D * 2 <= WIN_STRIDE && (size_t)MT * 16 * 4 <= 3 * MiB && (size_t)MT * 256 * 2 <= PE_STRIDE && (size_t)MT * D * 2 <= 33 * MiB && (size_t)MT * TW * 2 <= 65 * MiB, "ws map");
constexpr int CW_BAR = 4096;
constexpr int RING_OFF = 0, RING_BYTES = 131072;
constexpr int LDS_BYTES = 147456;
constexpr int LDSCTL_OFF = LDS_BYTES - 256, MISC_OFF = LDSCTL_OFF;

#define GAS __attribute__((address_space(1)))
#define LAS __attribute__((address_space(3)))
typedef unsigned short bf16;
typedef unsigned v4u __attribute__((ext_vector_type(4)));
typedef unsigned v2u __attribute__((ext_vector_type(2)));
typedef float f32x4 __attribute__((ext_vector_type(4)));
typedef float f32x2 __attribute__((ext_vector_type(2)));
typedef GAS unsigned gu32;
#define RLX_AGENT __ATOMIC_RELAXED, __HIP_MEMORY_SCOPE_AGENT
#define LDS_WAIT() asm volatile("s_waitcnt lgkmcnt(0)" ::: "memory")
#define VM_WAIT() asm volatile("s_waitcnt vmcnt(0)" ::: "memory")
__device__ __forceinline__ unsigned f2bf(float f) { unsigned u = __builtin_bit_cast(unsigned, f); return (u + 0x7fffu + ((u >> 16) & 1u)) >> 16; }
__device__ __forceinline__ unsigned pk2(float lo, float hi) { return f2bf(lo) | (f2bf(hi) << 16); }
__device__ __forceinline__ float bf_lo(unsigned u) { return __builtin_bit_cast(float, u << 16); }
__device__ __forceinline__ float bf_hi(unsigned u) { return __builtin_bit_cast(float, u & 0xffff0000u); }
__device__ __forceinline__ float sigmoidf_(float x) { return __builtin_amdgcn_rcpf(1.0f + __expf(-x)); }
__device__ __forceinline__ float siluf_(float x) { return x * sigmoidf_(x); }

#define XB_TMO      128
#define XB_XCNT(j)  (256  + 64 * (j))
#define XB_XSUB(j)  (1280 + 64 * (j))
#define XB_XGEN(j)  (2304 + 64 * (j))
#define XB_TOP      3328
#define XB_TOPGEN   3392
#define XCD_BAR_WORDS 3456
#define XB_SPIN_CAP (1u << 18)
__device__ __forceinline__ unsigned xb_ld(unsigned* p)              { return __hip_atomic_load(p, __ATOMIC_RELAXED, __HIP_MEMORY_SCOPE_AGENT); }
__device__ __forceinline__ unsigned xb_add(unsigned* p, unsigned v) { return __hip_atomic_fetch_add(p, v, __ATOMIC_RELAXED, __HIP_MEMORY_SCOPE_AGENT); }
__device__ __forceinline__ unsigned xb_xcc_id() { return (unsigned)__builtin_amdgcn_s_getreg((3 << 11) | 20) & 0xFu; }
#define XB_SPIN(cond, bar) do { unsigned _sp = 0; while (cond) { __builtin_amdgcn_s_sleep(1); \
    if ((++_sp & 255u) == 0u) { if (xb_ld(&(bar)[XB_TMO])) break; if (_sp > XB_SPIN_CAP) { atomicAdd(&(bar)[XB_TMO], 1u); break; } } } } while (0)
struct XcdBarrier { unsigned* bar; unsigned x; volatile LAS unsigned* st; };
__device__ __forceinline__ XcdBarrier xcd_barrier_post(unsigned* bar, volatile LAS unsigned* st) {
    XcdBarrier b; b.bar = bar; b.x = xb_xcc_id(); b.st = st;
    if (threadIdx.x == 0) (void)xb_add(&bar[XB_XCNT(b.x)], 1u);
    return b;
}
__device__ __forceinline__ void xcd_barrier_complete(unsigned* bar, unsigned x, unsigned& nloc, unsigned& nx) {
    const unsigned G = gridDim.x * gridDim.y * gridDim.z;
    unsigned sum, cnt, mine, sp = 0u;
    for (;;) {
        sum = 0u; cnt = 0u; mine = 0u;
#pragma unroll
        for (unsigned j = 0; j < 16; ++j) { const unsigned c = xb_ld(&bar[XB_XCNT(j)]); sum += c; cnt += (c > 0u) ? 1u : 0u; mine = (j == x) ? c : mine; }
        if (sum == G) break;
        __builtin_amdgcn_s_sleep(1);
        if ((++sp & 255u) == 0u) { if (xb_ld(&bar[XB_TMO])) break; if (sp > XB_SPIN_CAP) { atomicAdd(&bar[XB_TMO], 1u); break; } }
    }
    nloc = mine > 0u ? mine : 1u; nx = cnt > 0u ? cnt : 1u;
}
__device__ __forceinline__ void xcd_barrier(const XcdBarrier& b) {
    asm volatile("s_waitcnt vmcnt(0)" ::: "memory");
    __syncthreads();
    if (threadIdx.x == 0) {
        unsigned* bar = b.bar;
        __builtin_amdgcn_s_waitcnt(0);
        unsigned nloc = b.st[0], nx = b.st[1];
        if (nloc == 0u) { xcd_barrier_complete(bar, b.x, nloc, nx); b.st[0] = nloc; b.st[1] = nx; }
        const unsigned old = xb_add(&bar[XB_XSUB(b.x)], 1u);
        const unsigned gen = old / nloc;
        if (old + 1u == (gen + 1u) * nloc) {
            __builtin_amdgcn_fence(__ATOMIC_RELEASE, "agent");
            asm volatile("s_waitcnt vmcnt(0)" ::: "memory");
            const unsigned og = xb_add(&bar[XB_TOP], 1u);
            const unsigned tg = og / nx;
            if (og + 1u == (tg + 1u) * nx) xb_add(&bar[XB_TOPGEN], 1u);
            else XB_SPIN(xb_ld(&bar[XB_TOPGEN]) == tg, bar);
            __builtin_amdgcn_fence(__ATOMIC_ACQUIRE, "agent");
            xb_add(&bar[XB_XGEN(b.x)], 1u);
            asm volatile("s_waitcnt vmcnt(0)" ::: "memory");
        } else {
            XB_SPIN(xb_ld(&bar[XB_XGEN(b.x)]) == gen, bar);
            __builtin_amdgcn_fence(__ATOMIC_ACQUIRE, "agent");
            asm volatile("s_waitcnt vmcnt(0)" ::: "memory");
        }
    }
    __syncthreads();
}

struct Args { const float* in[20]; float* out; unsigned char* ws; int ph_lo, ph_hi, li, pad; };
enum { I_XP = 0, I_XS, I_SPOOL, I_SCONV, I_SSCONV, I_PP, I_PS, I_NORMG, I_WIN, I_WMIX, I_PSCALE, I_CBW, I_CBB, I_LNG, I_LNB, I_SCW, I_WOUT, I_WPLE, I_WGATE, I_FNG };
struct Frame {
    LAS unsigned char* lds;
    volatile LAS unsigned* MISC;
    gu32* ctl;
    int tid, lane, wave;
    int vcu, G;
    float* out;
    unsigned char* ws;
};
__device__ __forceinline__ bf16* ws_bf(const Frame& F, size_t off) { return (bf16*)(F.ws + off); }

__device__ __forceinline__ float wave_sum(float v) {
#pragma unroll
    for (int o = 1; o < 64; o <<= 1) v += __shfl_xor(v, o);
    return v;
}

using pg8::Unit; using pg8::cvt_pk_bf16;
__device__ __forceinline__ v4u pack8(const f32x4 a, const f32x4 b) { v4u w; w.x = cvt_pk_bf16(a[0], a[1]); w.y = cvt_pk_bf16(a[2], a[3]); w.z = cvt_pk_bf16(b[0], b[1]); w.w = cvt_pk_bf16(b[2], b[3]); return w; }
__device__ __forceinline__ f32x4 sig4(const f32x4 v) { return (f32x4){sigmoidf_(v[0]), sigmoidf_(v[1]), sigmoidf_(v[2]), sigmoidf_(v[3])}; }
__device__ __forceinline__ f32x4 silu4(const f32x4 v) { return v * sig4(v); }

__device__ __forceinline__ float* state_ptr(float* out, int layer, int row, int H, int C, size_t offP, size_t offS) {
    if (row < MP) { const int b = row >> 11, t = row & 2047, j = t - (SEQ - H); if (j < 0) return nullptr; return out + offP + ((size_t)(layer * NB + b) * H + j) * C; }
    const int s = row - MP; if (s >= NS) return nullptr; return out + offS + ((size_t)(layer * NS + s) * H + (H - 1)) * C;
}

struct EpiIn {
    static constexpr bool PERM = true, AFTER_DRAIN = false;
    bf16* T; const float* ssq; float* out; int layer;
    __device__ __forceinline__ void operator()(const f32x4 (&acc)[2][2][4][2], const Unit& u, int wr, int wc, int fr, int fq) const {
        const int pn = u.pn, pm = u.pm, cl = wc * 32 + 8 * fq, rowb = pm * 256 + wr * 64 + fr;
        const bool has_state = (pm == 64) || ((pm & 7) == 7);
        int ty, oc0, oc1 = 0, sc0 = 0;
        if (pn < 3) { ty = 0; oc0 = T_UB + 128 * pn; sc0 = 128 * pn; }
        else if (pn < 6) { ty = 1; oc0 = T_UC + 128 * (pn - 3); sc0 = 128 * (pn - 3); }
        else if (pn < 9) { ty = 2; oc0 = T_BZ + 128 * (pn - 6); }
        else if (pn == 9) { ty = 3; oc0 = T_VA; oc1 = T_VA + 128; }
        else if (pn == 10) { ty = 4; oc0 = T_SZA; oc1 = T_SZA + 128; }
        else if (pn == 11) { ty = 4; oc0 = T_SZB; oc1 = T_SZB + 128; }
        else { ty = 5; oc0 = T_SZB + 256; }
#pragma unroll
        for (int ai = 0; ai < 2; ++ai)
#pragma unroll
            for (int m = 0; m < 4; ++m) {
                const int row = rowb + ai * 128 + m * 16;
                const f32x4* sp = (const f32x4*)(ssq + (size_t)row * 16);
                const f32x4 s0 = sp[0], s1 = sp[1], s2 = sp[2], s3 = sp[3];
                const float ss = ((s0[0] + s0[1]) + (s0[2] + s0[3])) + ((s1[0] + s1[1]) + (s1[2] + s1[3])) + ((s2[0] + s2[1]) + (s2[2] + s2[3])) + ((s3[0] + s3[1]) + (s3[2] + s3[3]));
                const float rs = __builtin_amdgcn_rsqf(ss * (1.0f / D) + EPS);
                const f32x4 h0a = acc[ai][0][m][0] * rs, h0b = acc[ai][0][m][1] * rs, h1a = acc[ai][1][m][0] * rs, h1b = acc[ai][1][m][1] * rs;
                bf16* trow = T + (size_t)row * TW + cl;
                if (ty == 0 || ty == 1 || ty == 2) {
                    f32x4 oa, ob;
                    if (ty == 0) { oa = h0a * sig4(h1a); ob = h0b * sig4(h1b); }
                    else if (ty == 1) { oa = h0a * h1a; ob = h0b * h1b; }
                    else { oa = h0a * silu4(h1a); ob = h0b * silu4(h1b); }
                    *(v4u*)(trow + oc0) = pack8(oa, ob);
                    if (has_state && ty != 2) {
                        float* p = (ty == 0) ? state_ptr(out, layer, row, 30, 384, O_CONVP, O_CONVS) : state_ptr(out, layer, row, 2, 384, O_SCP, O_SCS);
                        if (p) { *(f32x4*)(p + sc0 + cl) = oa; *(f32x4*)(p + sc0 + cl + 4) = ob; }
                    }
                } else if (ty == 3) {
                    *(v4u*)(trow + oc0) = pack8(h0a, h0b); *(v4u*)(trow + oc1) = pack8(h1a, h1b);
                    if (has_state) { float* p = state_ptr(out, layer, row, 15, 256, O_POOLP, O_POOLS);
                        if (p) { *(f32x4*)(p + cl) = h0a; *(f32x4*)(p + cl + 4) = h0b; *(f32x4*)(p + 128 + cl) = h1a; *(f32x4*)(p + 128 + cl + 4) = h1b; } }
                } else if (ty == 4) {
                    *(v4u*)(trow + oc0) = pack8(silu4(h0a), silu4(h0b)); *(v4u*)(trow + oc1) = pack8(silu4(h1a), silu4(h1b));
                } else {
                    *(v4u*)(trow + oc0) = pack8(silu4(h0a), silu4(h0b));
                }
            }
    }
};

struct EpiOut {
    static constexpr bool PERM = true, AFTER_DRAIN = false;
    const float* xp; const float* xs; float* xres; bf16* xb; int layer;
    __device__ __forceinline__ void operator()(const f32x4 (&acc)[2][2][4][2], const Unit& u, int wr, int wc, int fr, int fq) const {
        const int cl = u.pn * 256 + wc * 32 + 8 * fq, rowb = u.pm * 256 + wr * 64 + fr;
#pragma unroll
        for (int ai = 0; ai < 2; ++ai)
#pragma unroll
            for (int m = 0; m < 4; ++m) {
                const int row = rowb + ai * 128 + m * 16;
                if (row < MROWS) {
                    const float* rin = (layer == 0) ? (row < MP ? xp + (size_t)row * D : xs + (size_t)(row - MP) * D) : xres + (size_t)row * D;
#pragma unroll
                    for (int bj = 0; bj < 2; ++bj) { const int col = cl + bj * 128;
                        const f32x4 a = *(const f32x4*)(rin + col), b = *(const f32x4*)(rin + col + 4);
                        const f32x4 v0 = acc[ai][bj][m][0] + a, v1 = acc[ai][bj][m][1] + b;
                        float* o = xres + (size_t)row * D + col; *(f32x4*)o = v0; *(f32x4*)(o + 4) = v1;
                        *(v4u*)(xb + (size_t)row * D + col) = pack8(v0, v1); }
                }
            }
    }
};

struct EpiPlain {
    static constexpr bool PERM = true, AFTER_DRAIN = false;
    bf16* O;
    __device__ __forceinline__ void operator()(const f32x4 (&acc)[2][2][4][2], const Unit& u, int wr, int wc, int fr, int fq) const {
        const int cl = u.pn * 256 + wc * 32 + 8 * fq, rowb = u.pm * 256 + wr * 64 + fr;
#pragma unroll
        for (int ai = 0; ai < 2; ++ai)
#pragma unroll
            for (int m = 0; m < 4; ++m) { const int row = rowb + ai * 128 + m * 16;
#pragma unroll
                for (int bj = 0; bj < 2; ++bj) *(v4u*)(O + (size_t)row * D + cl + bj * 128) = pack8(acc[ai][bj][m][0], acc[ai][bj][m][1]); }
    }
};

struct EpiGate {
    static constexpr bool PERM = true, AFTER_DRAIN = false;
    float* xres; const bf16* ple; bf16* xb; float* ssq;
    __device__ __forceinline__ void operator()(const f32x4 (&acc)[2][2][4][2], const Unit& u, int wr, int wc, int fr, int fq) const {
        const int cl = u.pn * 256 + wc * 32 + 8 * fq, rowb = u.pm * 256 + wr * 64 + fr;
#pragma unroll
        for (int ai = 0; ai < 2; ++ai)
#pragma unroll
            for (int m = 0; m < 4; ++m) {
                const int row = rowb + ai * 128 + m * 16;
                const bool valid = row < MROWS;
                float ss = 0.f;
#pragma unroll
                for (int bj = 0; bj < 2; ++bj) { const int col = cl + bj * 128;
                    float* o = xres + (size_t)row * D + col;
                    f32x4 a = (f32x4){0.f, 0.f, 0.f, 0.f}, b = a;
                    if (valid) { a = *(const f32x4*)o; b = *(const f32x4*)(o + 4); }
                    const v4u pw = *(const v4u*)(ple + (size_t)row * D + col);
                    const f32x4 pa = (f32x4){bf_lo(pw.x), bf_hi(pw.x), bf_lo(pw.y), bf_hi(pw.y)}, pb = (f32x4){bf_lo(pw.z), bf_hi(pw.z), bf_lo(pw.w), bf_hi(pw.w)};
                    const f32x4 v0 = a + pa * sig4(acc[ai][bj][m][0]), v1 = b + pb * sig4(acc[ai][bj][m][1]);
                    ss += (v0[0] * v0[0] + v0[1] * v0[1]) + (v0[2] * v0[2] + v0[3] * v0[3]) + (v1[0] * v1[0] + v1[1] * v1[1]) + (v1[2] * v1[2] + v1[3] * v1[3]);
                    if (valid) { *(f32x4*)o = v0; *(f32x4*)(o + 4) = v1; *(v4u*)(xb + (size_t)row * D + col) = pack8(v0, v1); }
                }
                ss += __shfl_xor(ss, 16); ss += __shfl_xor(ss, 32);
                if (fq == 0) ssq[(size_t)row * 16 + u.pn * 4 + wc] = ss;
            }
    }
};

__device__ __forceinline__ int in_half_src(int hh) {
    const int t = hh >> 1, h = hh & 1;
    if (t < 3) return (h ? 896 : 512) + 128 * t;
    if (t < 6) return (h ? 1664 : 2432) + 128 * (t - 3);
    if (t < 9) return (h ? 2816 : 2048) + 128 * (t - 6);
    if (t == 9) return h ? 128 : 0;
    if (t == 10) return h ? 384 : 256;
    if (t == 11) return h ? 1408 : 1280;
    return 1536;
}
__device__ __forceinline__ void p0_transpose_item(const float* W, int K, int N, int src_n0, bf16* WT, int dst_row0, const float* gscale, LAS float* scr, int k0, int lane) {
#pragma unroll 8
    for (int i = 0; i < 32; ++i) { const int kk = 2 * i + (lane >> 5); float w = W[(size_t)(k0 + kk) * N + src_n0 + (lane & 31)]; if (gscale) w *= gscale[k0 + kk]; scr[kk * 33 + (lane & 31)] = w; }
    LDS_WAIT(); asm volatile("" ::: "memory");
    const int c = lane & 7;
#pragma unroll
    for (int j = 0; j < 4; ++j) { const int n = (lane >> 3) + 8 * j; const LAS float* s = scr + (8 * c) * 33 + n;
        v4u o; o.x = pk2(s[0 * 33], s[1 * 33]); o.y = pk2(s[2 * 33], s[3 * 33]); o.z = pk2(s[4 * 33], s[5 * 33]); o.w = pk2(s[6 * 33], s[7 * 33]);
        *(GAS v4u*)(WT + (size_t)(dst_row0 + n) * K + k0 + 8 * c) = o; }
    LDS_WAIT(); asm volatile("" ::: "memory");
}
__device__ __forceinline__ void p0_prologue(Frame& F, const Args& A) {
    LAS float* scr = (LAS float*)(F.lds + RING_OFF + F.wave * 16384);
    const int gw = F.vcu * NWAVES + F.wave, NGW = F.G * NWAVES;
    constexpr int I_IN = 16 * 104, I_SQ = 16 * 32, I_PLE = 4 * 32, I_L = I_IN + 2 * I_SQ + I_PLE, NITEMS = 2 * I_L;
    for (int it = gw; it < NITEMS; it += NGW) {
        const int l = it / I_L; int r = it % I_L;
        if (r < I_IN) { const int kb = r / 104, nb = r % 104; p0_transpose_item(A.in[I_WIN] + (size_t)l * D * INC, D, INC, in_half_src(nb >> 2) + 32 * (nb & 3), ws_bf(F, WS_WIN + l * WIN_STRIDE), 32 * nb, A.in[I_NORMG] + l * D, scr, 64 * kb, F.lane); continue; } r -= I_IN;
        if (r < I_SQ) { const int kb = r / 32, nb = r % 32; p0_transpose_item(A.in[I_WOUT] + (size_t)l * D * D, D, D, 32 * nb, ws_bf(F, WS_WOUT + l * W1K_STRIDE), 32 * nb, nullptr, scr, 64 * kb, F.lane); continue; } r -= I_SQ;
        if (r < I_SQ) { const int kb = r / 32, nb = r % 32; p0_transpose_item(A.in[I_WGATE] + (size_t)l * D * D, D, D, 32 * nb, ws_bf(F, WS_WG + l * W1K_STRIDE), 32 * nb, nullptr, scr, 64 * kb, F.lane); continue; } r -= I_SQ;
        { const int kb = r / 32, nb = r % 32; p0_transpose_item(A.in[I_WPLE] + (size_t)l * PLED * D, PLED, D, 32 * nb, ws_bf(F, WS_WPLE + l * WPLE_STRIDE), 32 * nb, nullptr, scr, 64 * kb, F.lane); }
    }
    bf16* XB = ws_bf(F, WS_XBA); float* SSQ = (float*)(F.ws + WS_SSQ);
    for (int m = gw; m < MROWS; m += NGW) {
        const float* xrow = m < MP ? A.in[I_XP] + (size_t)m * D : A.in[I_XS] + (size_t)(m - MP) * D;
        const GAS f32x4* xr = (const GAS f32x4*)xrow + F.lane;
        f32x4 v[4]; float s = 0.f;
#pragma unroll
        for (int j = 0; j < 4; ++j) { v[j] = xr[64 * j]; s += (v[j].x * v[j].x + v[j].y * v[j].y) + (v[j].z * v[j].z + v[j].w * v[j].w); }
        s = wave_sum(s);
        GAS v2u* o8 = (GAS v2u*)(XB + (size_t)m * D) + F.lane;
#pragma unroll
        for (int j = 0; j < 4; ++j) o8[64 * j] = (v2u){pk2(v[j].x, v[j].y), pk2(v[j].z, v[j].w)};
        if (F.lane < 16) SSQ[(size_t)m * 16 + F.lane] = (F.lane == 0) ? s : 0.f;
    }
    for (int it = gw; it < 2 * MROWS; it += NGW) {
        const int l = it / MROWS, m = it % MROWS;
        const float* prow = m < MP ? A.in[I_PP] + ((size_t)l * MP + m) * PLED : A.in[I_PS] + ((size_t)l * NS + (m - MP)) * PLED;
        const f32x4 v = ((const GAS f32x4*)prow)[F.lane];
        ((GAS v2u*)(ws_bf(F, WS_PE + l * PE_STRIDE) + (size_t)m * PLED))[F.lane] = (v2u){pk2(v.x, v.y), pk2(v.z, v.w)};
    }
    { const int gt0 = F.vcu * (NWAVES * 64) + F.tid, NGT0 = F.G * NWAVES * 64;
      for (int i = gt0; i < 2 * NS * (192 + 128 + 192); i += NGT0) {
          if (i < 2 * NS * 192) { const int ls = i / 192, ch = 2 * (i % 192), l = ls / NS;
              const float* st = A.in[I_SCONV] + (size_t)ls * 30 * WB + ch; const float* cw = A.in[I_CBW] + (size_t)l * 31 * WB + ch;
              f32x2 a = *(const GAS f32x2*)(A.in[I_CBB] + l * WB + ch);
#pragma unroll 10
              for (int k = 0; k < 30; ++k) a += *(const GAS f32x2*)(cw + k * WB) * *(const GAS f32x2*)(st + k * WB);
              *(GAS f32x2*)((float*)(F.ws + WS_PSB) + (size_t)ls * WB + ch) = a; }
          else if (i < 2 * NS * 320) { const int i2 = i - 2 * NS * 192, ls = i2 / 128, cp = i2 % 128, ch = 2 * cp, w = 2 << (cp >> 5);
              const float* st = A.in[I_SPOOL] + (size_t)ls * 15 * WA + ch; f32x2 a = (f32x2){0.f, 0.f};
              for (int j = 1; j < w; ++j) a += *(const GAS f32x2*)(st + (15 - j) * WA);
              *(GAS f32x2*)((float*)(F.ws + WS_PSA) + (size_t)ls * WA + ch) = a; }
          else { const int i2 = i - 2 * NS * 320, ls = i2 / 192, ch = 2 * (i2 % 192), l = ls / NS;
              const float* st = A.in[I_SSCONV] + (size_t)ls * 2 * WC + ch; const float* w = A.in[I_SCW] + (size_t)l * 3 * WC + ch;
              *(GAS f32x2*)((float*)(F.ws + WS_PSC) + (size_t)ls * WC + ch) = *(const GAS f32x2*)w * *(const GAS f32x2*)st + *(const GAS f32x2*)(w + WC) * *(const GAS f32x2*)(st + WC); }
      } }
    const int gt = F.vcu * (NWAVES * 64) + F.tid, NGT = F.G * NWAVES * 64;
    for (int i = gt; i < 2 * NS * 14 * 64; i += NGT) { const int ls = i / (14 * 64), r = i % (14 * 64);
        ((GAS f32x4*)(F.out + O_POOLS + (size_t)ls * 15 * 256))[r] = ((const GAS f32x4*)(A.in[I_SPOOL] + (size_t)ls * 15 * 256 + 256))[r]; }
    for (int i = gt; i < 2 * NS * 29 * 96; i += NGT) { const int ls = i / (29 * 96), r = i % (29 * 96);
        ((GAS f32x4*)(F.out + O_CONVS + (size_t)ls * 30 * 384))[r] = ((const GAS f32x4*)(A.in[I_SCONV] + (size_t)ls * 30 * 384 + 384))[r]; }
    for (int i = gt; i < 2 * NS * 96; i += NGT) { const int ls = i / 96, r = i % 96;
        ((GAS f32x4*)(F.out + O_SCS + (size_t)ls * 2 * 384))[r] = ((const GAS f32x4*)(A.in[I_SSCONV] + (size_t)ls * 2 * 384 + 384))[r]; }
}

__device__ __forceinline__ int opaque0() { int z; asm volatile("s_mov_b32 %0, 0" : "=s"(z)); return z; }
__device__ __forceinline__ f32x2 ldbf2(const bf16* p) { const unsigned u = *(const GAS unsigned*)p; return (f32x2){bf_lo(u), bf_hi(u)}; }
typedef short bf16x8_t __attribute__((ext_vector_type(8)));
constexpr int MX_CWS = 0, MX_UBS = 47616, MX_VAS = 82944, MX_CB = 98816, MX_PLB = 123392, MX_END = 131840, PLB_LD = 264;
constexpr int MX_NCH_UB = 46 * 48, MX_NCH = MX_NCH_UB + 31 * 32;
static_assert(MX_END <= LDSCTL_OFF, "mixer LDS map");
__device__ __forceinline__ void mixer_phase(Frame& F, const Args& A, int layer) {
    LAS float* CWS = (LAS float*)(F.lds + MX_CWS);
    LAS unsigned* UBS = (LAS unsigned*)(F.lds + MX_UBS);
    LAS unsigned* VAS = (LAS unsigned*)(F.lds + MX_VAS);
    LAS float* CB = (LAS float*)(F.lds + MX_CB);
    LAS bf16* PLB = (LAS bf16*)(F.lds + MX_PLB);
    const bf16* T = ws_bf(F, WS_T); bf16* Y = ws_bf(F, WS_Y);
    const int tid = F.tid + opaque0(), lane = tid & 63, wave = F.wave, fr = lane & 15, fq = lane >> 4;
    { const GAS f32x4* cwg = (const GAS f32x4*)(A.in[I_CBW] + (size_t)layer * 31 * WB);
      for (int i = tid; i < 31 * 96; i += 512) ((LAS f32x4*)CWS)[i] = cwg[i]; }
    bf16x8_t wf[2][2];
    { const float* wm = A.in[I_WMIX] + (size_t)layer * 16384 + (size_t)(wave >> 1) * 4096;
#pragma unroll
      for (int a = 0; a < 2; ++a)
#pragma unroll
          for (int ks = 0; ks < 2; ++ks) { const float* p = wm + (32 * ks + 8 * fq) * 64 + 16 * (2 * (wave & 1) + a) + fr;
              v4u w; w.x = pk2(p[0], p[64]); w.y = pk2(p[128], p[192]); w.z = pk2(p[256], p[320]); w.w = pk2(p[384], p[448]); wf[a][ks] = __builtin_bit_cast(bf16x8_t, w); } }
    const float* cbias = A.in[I_CBB] + layer * WB; const float* lg = A.in[I_LNG] + layer * WB; const float* lb = A.in[I_LNB] + layer * WB;
    const float* sw = A.in[I_SCW] + layer * 3 * WC; const float* psc = A.in[I_PSCALE] + layer * WA;
    const float* PSB = (const float*)(F.ws + WS_PSB) + (size_t)layer * NS * WB; const float* PSA = (const float*)(F.ws + WS_PSA) + (size_t)layer * NS * WA; const float* PSC = (const float*)(F.ws + WS_PSC) + (size_t)layer * NS * WC;
    v4u pf[7];
#define MX_PREFETCH(uu) do { const int r0_ = (uu) * 16, t0_ = r0_ & 2047; _Pragma("unroll") for (int i_ = 0; i_ < 7; ++i_) { const int c_ = tid + 512 * i_; v4u v_ = (v4u){0u, 0u, 0u, 0u}; \
        if (c_ < MX_NCH_UB) { const int j_ = c_ / 48, cc_ = c_ % 48; if (t0_ - 30 + j_ >= 0) v_ = *(const GAS v4u*)(T + (size_t)(r0_ - 30 + j_) * TW + T_UB + cc_ * 8); } \
        else if (c_ < MX_NCH) { const int c2_ = c_ - MX_NCH_UB, j_ = c2_ >> 5, cc_ = c2_ & 31; if (t0_ - 15 + j_ >= 0) v_ = *(const GAS v4u*)(T + (size_t)(r0_ - 15 + j_) * TW + T_VA + cc_ * 8); } \
        pf[i_] = v_; } } while (0)
    int u = blockIdx.x;
    if (u < 1024) MX_PREFETCH(u);
    for (; u < 1032; u += gridDim.x) {
        const bool smp = u >= 1024;
        const int row0 = smp ? MP + (u - 1024) * 16 : u * 16;
        const int t0 = smp ? 0 : (row0 & 2047);
        __syncthreads();
        if (!smp) {
#pragma unroll
            for (int i = 0; i < 7; ++i) { const int c = tid + 512 * i;
                if (c < MX_NCH_UB) *(LAS v4u*)(UBS + 4 * c) = pf[i]; else if (c < MX_NCH) *(LAS v4u*)(VAS + 4 * (c - MX_NCH_UB)) = pf[i]; }
        }
        { const int un = u + gridDim.x; if (un < 1024) MX_PREFETCH(un); }
        __syncthreads();
        if (tid < 384) {
            const int tz = tid + opaque0(), cp = tz % 192, tb = tz / 192, ch = 2 * cp;
            if (!smp) {
                const f32x2 bias = *(const GAS f32x2*)(cbias + ch);
                const LAS unsigned* ub = UBS + (8 * tb) * 192 + cp;
                f32x2 in[38];
#pragma unroll
                for (int j = 0; j < 38; ++j) { const unsigned w = ub[j * 192]; in[j] = (f32x2){bf_lo(w), bf_hi(w)}; }
                f32x2 a[8];
#pragma unroll
                for (int i = 0; i < 8; ++i) a[i] = bias;
#pragma unroll
                for (int k = 0; k < 31; ++k) { const f32x2 w = *(const LAS f32x2*)(CWS + k * WB + ch);
#pragma unroll
                    for (int i = 0; i < 8; ++i) a[i] += w * in[i + k]; }
#pragma unroll
                for (int i = 0; i < 8; ++i) *(LAS f32x2*)(CB + (8 * tb + i) * WB + ch) = a[i];
            } else {
                const f32x2 w30 = *(const LAS f32x2*)(CWS + 30 * WB + ch);
#pragma unroll
                for (int i = 0; i < 8; ++i) { const int s = (u - 1024) * 16 + 8 * tb + i;
                    *(LAS f32x2*)(CB + (8 * tb + i) * WB + ch) = *(const GAS f32x2*)(PSB + (size_t)s * WB + ch) + w30 * ldbf2(T + (size_t)(MP + s) * TW + T_UB + ch); }
            }
        }
        { const int lz = lane + opaque0();
#pragma unroll
          for (int q = 0; q < 4; ++q) { const int wt = wave + 8 * q, g = wt & 3, tk = 2 * (wt >> 2) + (lz >> 5), cp = 32 * g + (lz & 31), w = 2 << g;
              f32x2 s, v;
              if (!smp) { const LAS unsigned* vr = VAS + (15 + tk) * 128 + cp; const unsigned x0 = vr[0]; v = (f32x2){bf_lo(x0), bf_hi(x0)}; s = v;
                  for (int j = 1; j < w; ++j) { const unsigned x = vr[-j * 128]; s += (f32x2){bf_lo(x), bf_hi(x)}; }
                  const int t = t0 + tk; s = s * (1.0f / (float)(w < t + 1 ? w : t + 1)); }
              else { const int sq = (u - 1024) * 16 + tk; v = ldbf2(T + (size_t)(MP + sq) * TW + T_VA + 2 * cp); s = (*(const GAS f32x2*)(PSA + (size_t)sq * WA + 2 * cp) + v) * (1.0f / (float)w); }
              s = s - v;
              *(LAS unsigned*)(PLB + tk * PLB_LD + 2 * cp) = pk2(s.x, s.y); } }
        __syncthreads();
        const int tze = tid + opaque0();
        unsigned eu0[6], eu1[6], eu2[6], ebz[6];
#pragma unroll
        for (int q = 0; q < 6; ++q) { const int task = tze + 512 * q, tk = task / 192, cp = task % 192, ch = 2 * cp, row = row0 + tk, t = t0 + tk;
            const bf16* p = T + (size_t)row * TW + T_UC + ch;
            eu0[q] = *(const GAS unsigned*)p; ebz[q] = *(const GAS unsigned*)(p + (T_BZ - T_UC));
            eu1[q] = (!smp && t >= 1) ? *(const GAS unsigned*)(p - TW) : 0u; eu2[q] = (!smp && t >= 2) ? *(const GAS unsigned*)(p - 2 * TW) : 0u; }
        { const int lz = lane + opaque0();
#pragma unroll
          for (int q = 0; q < 2; ++q) { const int tk = 2 * wave + q, row = row0 + tk;
            f32x2 x[3]; float s = 0.f;
#pragma unroll
            for (int j = 0; j < 3; ++j) { x[j] = *(LAS f32x2*)(CB + tk * WB + 128 * j + 2 * lz); s += x[j].x + x[j].y; }
            const float mean = wave_sum(s) * (1.0f / WB); float s2 = 0.f;
#pragma unroll
            for (int j = 0; j < 3; ++j) { x[j] = x[j] - mean; s2 += x[j].x * x[j].x + x[j].y * x[j].y; }
            const float rstd = __builtin_amdgcn_rsqf(wave_sum(s2) * (1.0f / WB) + EPS);
#pragma unroll
            for (int j = 0; j < 3; ++j) { const int ch = 128 * j + 2 * lz;
                const f32x2 g = *(const GAS f32x2*)(lg + ch), b = *(const GAS f32x2*)(lb + ch), z = ldbf2(T + (size_t)row * TW + T_SZB + ch);
                const f32x2 y = x[j] * rstd * g + b;
                *(GAS unsigned*)(Y + (size_t)row * D + WA + ch) = pk2(siluf_(y.x) * z.x, siluf_(y.y) * z.y); }
          } }
        { const int g = wave >> 1;
          const bf16x8_t p0 = *(const LAS bf16x8_t*)(PLB + fr * PLB_LD + 64 * g + 8 * fq), p1 = *(const LAS bf16x8_t*)(PLB + fr * PLB_LD + 64 * g + 32 + 8 * fq);
#pragma unroll
          for (int a = 0; a < 2; ++a) {
              f32x4 acc = (f32x4){0.f, 0.f, 0.f, 0.f};
              acc = __builtin_amdgcn_mfma_f32_16x16x32_bf16(wf[a][0], p0, acc, 0, 0, 0);
              acc = __builtin_amdgcn_mfma_f32_16x16x32_bf16(wf[a][1], p1, acc, 0, 0, 0);
              const int ch = 64 * g + 16 * (2 * (wave & 1) + a) + 4 * fq, row = row0 + fr;
              const f32x4 sc = *(const GAS f32x4*)(psc + ch); const v2u zz = *(const GAS v2u*)(T + (size_t)row * TW + T_SZA + ch);
              *(GAS v2u*)(Y + (size_t)row * D + ch) = (v2u){pk2(acc[0] * sc[0] * bf_lo(zz.x), acc[1] * sc[1] * bf_hi(zz.x)), pk2(acc[2] * sc[2] * bf_lo(zz.y), acc[3] * sc[3] * bf_hi(zz.y))}; } }
#pragma unroll
        for (int q = 0; q < 6; ++q) { const int task = tze + 512 * q, tk = task / 192, cp = task % 192, ch = 2 * cp, row = row0 + tk;
            const f32x2 w2 = *(const GAS f32x2*)(sw + 2 * WC + ch); f32x2 s = w2 * (f32x2){bf_lo(eu0[q]), bf_hi(eu0[q])};
            if (!smp) s += *(const GAS f32x2*)(sw + ch) * (f32x2){bf_lo(eu2[q]), bf_hi(eu2[q])} + *(const GAS f32x2*)(sw + WC + ch) * (f32x2){bf_lo(eu1[q]), bf_hi(eu1[q])};
            else s += *(const GAS f32x2*)(PSC + (size_t)(row - MP) * WC + ch);
            *(GAS unsigned*)(Y + (size_t)row * D + WA + WB + ch) = pk2(s.x * bf_lo(ebz[q]), s.y * bf_hi(ebz[q])); }
    }
#undef MX_PREFETCH
    __syncthreads();
}

__device__ __forceinline__ void final_norm_phase(Frame& F, const Args& A) {
    const int gw = F.vcu * NWAVES + F.wave, NGW = F.G * NWAVES;
    const float* SSQ = (const float*)(F.ws + WS_SSQ);
    f32x4 g[4];
#pragma unroll
    for (int j = 0; j < 4; ++j) g[j] = ((const GAS f32x4*)A.in[I_FNG])[F.lane + 64 * j];
    for (int m = gw; m < MROWS; m += NGW) {
        float s = (F.lane < 16) ? SSQ[(size_t)m * 16 + F.lane] : 0.f;
        s = wave_sum(s);
        const float rs = __builtin_amdgcn_rsqf(s * (1.0f / D) + EPS);
        GAS f32x4* xr = (GAS f32x4*)(F.out + (size_t)m * D) + F.lane;
#pragma unroll
        for (int j = 0; j < 4; ++j) { const f32x4 v = xr[64 * j]; xr[64 * j] = v * rs * g[j]; }
    }
}

__global__ void __launch_bounds__(NWAVES * 64, 2) mk_fwd(Args args) {
    extern __shared__ __attribute__((aligned(16))) unsigned char lds[];
    Frame F;
    F.lds = (LAS unsigned char*)lds;
    F.MISC = (volatile LAS unsigned*)(F.lds + MISC_OFF);
    F.tid = threadIdx.x; F.lane = F.tid & 63; F.wave = __builtin_amdgcn_readfirstlane(F.tid >> 6);
    F.G = gridDim.x; { const int bx = blockIdx.x; F.vcu = (F.G % 8 == 0) ? (bx % 8) * (F.G / 8) + bx / 8 : bx; }
    F.ws = args.ws; F.out = args.out;
    F.ctl = (gu32*)(args.ws + WS_CTL);
    for (int u = F.tid; u < (LDS_BYTES - LDSCTL_OFF) / 4; u += NWAVES * 64) ((LAS unsigned*)(F.lds + LDSCTL_OFF))[u] = 0u;
    __syncthreads();
    XcdBarrier bar; bar.bar = (unsigned*)(F.ctl + CW_BAR); bar.x = 0; bar.st = nullptr;
    if (N_LAUNCHES == 1) bar = xcd_barrier_post((unsigned*)(F.ctl + CW_BAR), F.MISC + 8);
#define GRID_BAR() do { if (N_LAUNCHES == 1) xcd_barrier(bar); } while (0)
    const int lo = args.ph_lo, hi = args.ph_hi;
#define IN(k) (lo <= (k) && (k) < hi)
#define BOTH(k) (IN(k) && IN((k) + 1))
    float* SSQ = (float*)(F.ws + WS_SSQ);
    if (IN(0)) {
#ifndef SKIP_P0
        p0_prologue(F, args);
#endif
        if (BOTH(0)) GRID_BAR(); }
#pragma unroll 1
    for (int l = 0; l < 2; ++l) {
        const int pb = 1 + 4 * l;
        bf16* XBA = ws_bf(F, WS_XBA); bf16* XBB = ws_bf(F, WS_XBB);
        if (IN(pb)) {
            pg8::Gemm g{XBA, ws_bf(F, WS_WIN + l * WIN_STRIDE), MT, NIN, D}; pg8::StaticOrder S; S.init(MT, NIN, F.G, (int)blockIdx.x);
            EpiIn E{ws_bf(F, WS_T), SSQ, F.out, l};
#ifndef SKIP_GIN
            pg8::gemm_phase<EpiIn, pg8::StaticOrder, PG8_ALIGN, PG8_SP2>(F.lds + RING_OFF, g, S, E);
#endif
            if (BOTH(pb)) GRID_BAR();
        }
        if (IN(pb + 1)) {
#ifndef SKIP_MIX
            mixer_phase(F, args, l);
#endif
            if (BOTH(pb + 1)) GRID_BAR(); }
        if (IN(pb + 2)) {
            { pg8::Gemm g{ws_bf(F, WS_Y), ws_bf(F, WS_WOUT + l * W1K_STRIDE), MT, D, D}; pg8::StaticOrder S; S.init(MT, D, F.G, (int)blockIdx.x);
              EpiOut E{args.in[I_XP], args.in[I_XS], F.out, XBB, l};
#ifndef SKIP_GOUT
              pg8::gemm_phase<EpiOut, pg8::StaticOrder, PG8_ALIGN, PG8_SP2>(F.lds + RING_OFF, g, S, E);
#endif
            }
            { pg8::Gemm g{ws_bf(F, WS_PE + l * PE_STRIDE), ws_bf(F, WS_WPLE + l * WPLE_STRIDE), MT, D, PLED}; pg8::StaticOrder S; S.init(MT, D, F.G, (int)blockIdx.x);
              EpiPlain E{ws_bf(F, WS_PLEO)};
#ifndef SKIP_GPLE
              pg8::gemm_phase<EpiPlain, pg8::StaticOrder, PG8_ALIGN, PG8_SP2>(F.lds + RING_OFF, g, S, E);
#endif
            }
            if (BOTH(pb + 2)) GRID_BAR();
        }
        if (IN(pb + 3)) {
            pg8::Gemm g{XBB, ws_bf(F, WS_WG + l * W1K_STRIDE), MT, D, D}; pg8::StaticOrder S; S.init(MT, D, F.G, (int)blockIdx.x);
            EpiGate E{F.out, ws_bf(F, WS_PLEO), XBA, SSQ};
#ifndef SKIP_GGATE
            pg8::gemm_phase<EpiGate, pg8::StaticOrder, PG8_ALIGN, PG8_SP2>(F.lds + RING_OFF, g, S, E);
#endif
            if (BOTH(pb + 3)) GRID_BAR();
        }
    }
#ifndef SKIP_FN
    if (IN(9)) final_norm_phase(F, args);
#endif
#undef IN
#undef BOTH
}

extern "C" void kernel_launch(void* const* d_in, const int* in_sizes, int n_in, void* d_out, int out_size, void* d_ws, size_t ws_size, hipStream_t stream) {
    static int grid = 0;
    if (grid == 0) {
        if (n_in != 20 || out_size != (int)O_END || ws_size < WS_END) { fprintf(stderr, "kernel_launch: unexpected shapes: n_in %d out %d ws %zu\n", n_in, out_size, ws_size); grid = -1; return; }
        int dev = 0, cus = 0, per_cu = 0;
        if (hipGetDevice(&dev) != hipSuccess || hipDeviceGetAttribute(&cus, hipDeviceAttributeMultiprocessorCount, dev) != hipSuccess) { grid = -1; return; }
        if (hipFuncSetAttribute((const void*)mk_fwd, hipFuncAttributeMaxDynamicSharedMemorySize, LDS_BYTES) != hipSuccess) { fprintf(stderr, "kernel_launch: hipFuncSetAttribute failed\n"); grid = -1; return; }
        if (hipOccupancyMaxActiveBlocksPerMultiprocessor(&per_cu, (const void*)mk_fwd, NWAVES * 64, LDS_BYTES) != hipSuccess || per_cu < 1)
            fprintf(stderr, "kernel_launch: occupancy query reports %d workgroups per CU\n", per_cu);
        (void)hipGetLastError();
        grid = cus;
    }
    if (grid < 0) return;
    (void)hipMemsetAsync((char*)d_ws + WS_CTL, 0, CTL_ZERO_BYTES, stream);
    Args a{};
    for (int i = 0; i < 20; ++i) a.in[i] = (const float*)d_in[i];
    a.out = (float*)d_out; a.ws = (unsigned char*)d_ws;
    if (N_LAUNCHES == 1) { a.ph_lo = 0; a.ph_hi = N_PHASES; a.li = 0; hipLaunchKernelGGL(mk_fwd, dim3(grid), dim3(NWAVES * 64), LDS_BYTES, stream, a); }
    else for (int li = 0; li < N_PHASES; ++li) { a.ph_lo = li; a.ph_hi = li + 1; a.li = li; hipLaunchKernelGGL(mk_fwd, dim3(grid), dim3(NWAVES * 64), LDS_BYTES, stream, a); }
}
```

```cpp
#include <hip/hip_runtime.h>
#include <cstdio>
#include <cstdint>

#ifndef MK_N_LAUNCHES
#define MK_N_LAUNCHES 1
#endif

namespace pg8 {
#define PG8_LAS __attribute__((address_space(3)))
typedef unsigned short bf16_t;
typedef short bf16x8 __attribute__((ext_vector_type(8)));
typedef float f32x4 __attribute__((ext_vector_type(4)));
typedef unsigned u32x4 __attribute__((ext_vector_type(4)));
typedef unsigned u32x2 __attribute__((ext_vector_type(2)));
constexpr int BM = 256, BK = 64, HALF = 128, HTB = HALF * BK * 2  , STAGE_BYTES = 8 * HTB, NXCD = 8, WGM = 8;

__host__ __device__ __forceinline__ int lds_byte(int r, int c) { const int st = (r >> 4) * 2 + (c >> 5), rr = r & 15, cc = c & 31, ob = rr * 64 + cc * 2; return st * 1024 + (ob ^ (((ob >> 9) & 1) << 5)); }
__host__ __device__ __forceinline__ void stage_rc(int b, int& R, int& C) { const int st = b / 1024, sb = b % 1024, swz = sb ^ (((sb >> 9) & 1) << 5); R = (st >> 1) * 16 + swz / 64; C = (st & 1) * 32 + (swz % 64) / 2; }
__host__ __device__ __forceinline__ int perm32(int rho) { const int n = rho >> 4, i = rho & 15; return 8 * (i >> 2) + 4 * n + (i & 3); }

struct Unit { int pm, pn; };
struct Gemm { const bf16_t* A; const bf16_t* Bt; int M, N, K; };

struct StaticOrder {
    int nM, nN, nwg, G, c;
    __host__ __device__ void init(int M, int N, int G_, int c_) { nM = M / BM; nN = N / BM; nwg = nM * nN; G = G_; c = c_; }
    __host__ __device__ bool next(int i, Unit& u) const {
        const long L = (long)i * G + c; if (L >= nwg) return false;
        int wgid = (int)L; { const int q = nwg / NXCD, r = nwg % NXCD, xcd = wgid % NXCD, off = wgid / NXCD; wgid = (xcd < r ? xcd * (q + 1) : r * (q + 1) + (xcd - r) * q) + off; }
        const int nig = WGM * nN, gid = wgid / nig, fm = gid * WGM, gsz = (nM - fm) < WGM ? (nM - fm) : WGM;
        u.pm = fm + ((wgid % nig) % gsz); u.pn = (wgid % nig) / gsz; return true;
    }
    __device__ __forceinline__ void a_ready(const Unit&) const {}
    __device__ __forceinline__ void done(const Unit&) const {}
};

__device__ __forceinline__ unsigned cvt_pk_bf16(float lo, float hi) { unsigned r; asm volatile("v_cvt_pk_bf16_f32 %0, %1, %2" : "=v"(r) : "v"(lo), "v"(hi)); return r; }

template <class Epi, class Sched, bool ALIGN_EPI = false, bool SP2 = false>
__device__ __forceinline__ void gemm_phase(PG8_LAS unsigned char* lds, const Gemm g, const Sched& S, const Epi& E) {
    int tz0; asm volatile("s_mov_b32 %0, 0" : "=s"(tz0));
    const int tid = threadIdx.x + tz0, wid = __builtin_amdgcn_readfirstlane(tid >> 6), lane = tid & 63, wr = wid >> 2, wc = wid & 3, fr = lane & 15, fq = lane >> 4;
    const int K = g.K, nt = K / BK;
    unsigned voffA[2], voffB[2];
#pragma unroll
    for (int i = 0; i < 2; ++i) { int R, C; stage_rc(tid * 16 + i * 8192, R, C); const int Rb = Epi::PERM ? ((R & ~31) + perm32(R & 31)) : R;
        voffA[i] = (unsigned)(R * K + C) * 2u; voffB[i] = (unsigned)(Rb * K + C) * 2u; }
    const size_t kstep = (size_t)(BK * 2);
    const size_t hstep = (size_t)HALF * K * 2;
    const size_t tstep = 2 * hstep;
    const unsigned ldsw = (unsigned)wid * 1024u;
    const int aoff = lds_byte(wr * 64 + fr, fq * 8), boff = lds_byte(wc * 32 + fr, fq * 8);
#define PG8_SA(b, h) (((b) * 2 + (h)) * HTB)
#define PG8_SB(b, h) ((4 + (b) * 2 + (h)) * HTB)
#define PG8_STAGE(bufoff, gbase, voff) do { _Pragma("unroll") for (int _i = 0; _i < 2; ++_i) \
        __builtin_amdgcn_global_load_lds((const unsigned*)((const char*)(gbase) + (voff)[_i]), (PG8_LAS unsigned*)(lds + (bufoff) + ldsw + _i * 8192), 16, 0, 0); } while (0)
#define PG8_LDA(dst, b, h) do { _Pragma("unroll") for (int m = 0; m < 4; ++m) _Pragma("unroll") for (int k = 0; k < 2; ++k) dst[m][k] = *(const PG8_LAS bf16x8*)(lds + PG8_SA(b, h) + aoff + m * 2048 + k * 1024); } while (0)
#define PG8_LDB(dst, b, h) do { _Pragma("unroll") for (int n = 0; n < 2; ++n) _Pragma("unroll") for (int k = 0; k < 2; ++k) dst[n][k] = *(const PG8_LAS bf16x8*)(lds + PG8_SB(b, h) + boff + n * 2048 + k * 1024); } while (0)
#define PG8_MMA(ai, bj, At, Bt) do { __builtin_amdgcn_s_setprio(1); _Pragma("unroll") for (int m = 0; m < 4; ++m) _Pragma("unroll") for (int n = 0; n < 2; ++n) _Pragma("unroll") for (int k = 0; k < 2; ++k) \
        acc[ai][bj][m][n] = __builtin_amdgcn_mfma_f32_16x16x32_bf16(Bt[n][k], At[m][k], acc[ai][bj][m][n], 0, 0, 0); __builtin_amdgcn_s_setprio(0); } while (0)
#define PG8_WAIT_V(n) asm volatile("s_waitcnt vmcnt(" #n ")" ::: "memory")
#define PG8_WAIT_L(n) asm volatile("s_waitcnt lgkmcnt(" #n ")" ::: "memory")
#define PG8_BAR __builtin_amdgcn_s_barrier()
#define PG8_SCHED __builtin_amdgcn_sched_barrier(0)
    Unit cur, nxt; int ui = 0;
    if (!S.next(0, cur)) return;
    f32x4 acc[2][2][4][2];
#pragma unroll
    for (int a = 0; a < 2; ++a)
#pragma unroll
        for (int b = 0; b < 2; ++b)
#pragma unroll
            for (int m = 0; m < 4; ++m)
#pragma unroll
                for (int n = 0; n < 2; ++n) acc[a][b][m][n] = (f32x4){0.f, 0.f, 0.f, 0.f};
    bf16x8 At[4][2], B0[2][2], B1[2][2];
    const char* cA = (const char*)g.A + (size_t)cur.pm * tstep; const char* cB = (const char*)g.Bt + (size_t)cur.pn * tstep;
    S.a_ready(cur);
    if constexpr (SP2) {
        PG8_STAGE(PG8_SB(0, 0), cB, voffB); PG8_STAGE(PG8_SB(0, 1), cB + hstep, voffB); PG8_STAGE(PG8_SA(0, 0), cA, voffA); PG8_STAGE(PG8_SA(0, 1), cA + hstep, voffA);
        if (wr == 1) PG8_BAR;
        PG8_WAIT_V(2); PG8_BAR;
        PG8_STAGE(PG8_SB(1, 0), cB + kstep, voffB); PG8_STAGE(PG8_SA(1, 0), cA + kstep, voffA); PG8_STAGE(PG8_SB(1, 1), cB + hstep + kstep, voffB);
        PG8_WAIT_V(6); PG8_BAR;
    } else {
        PG8_STAGE(PG8_SB(0, 0), cB, voffB); PG8_STAGE(PG8_SA(0, 0), cA, voffA); PG8_STAGE(PG8_SB(0, 1), cB + hstep, voffB); PG8_STAGE(PG8_SA(0, 1), cA + hstep, voffA);
        if (wr == 1) PG8_BAR;
        PG8_WAIT_V(4); PG8_BAR;
        PG8_STAGE(PG8_SB(1, 0), cB + kstep, voffB); PG8_STAGE(PG8_SA(1, 0), cA + kstep, voffA); PG8_STAGE(PG8_SB(1, 1), cB + hstep + kstep, voffB);
        PG8_WAIT_V(6); PG8_BAR;
    }
    for (;;) {
        const bool has_next = S.next(ui + 1, nxt);
        const char* nA = has_next ? (const char*)g.A + (size_t)nxt.pm * tstep : cA; const char* nB = has_next ? (const char*)g.Bt + (size_t)nxt.pn * tstep : cB;
#pragma unroll 1
        for (int t = 0; t < nt; t += 2) {
            const bool last = (t == nt - 2);
            const char* a1 = cA + (size_t)(t + 1) * kstep;
            const char* a2 = last ? nA : cA + (size_t)(t + 2) * kstep; const char* b2 = last ? nB : cB + (size_t)(t + 2) * kstep;
            const char* a3 = a2 + kstep; const char* b3 = b2 + kstep;
            if (last && has_next) S.a_ready(nxt);
            if constexpr (SP2) {
            PG8_LDB(B0, 0, 0); PG8_LDB(B1, 0, 1); PG8_SCHED; PG8_LDA(At, 0, 0); PG8_STAGE(PG8_SA(1, 1), a1 + hstep, voffA);
            PG8_WAIT_V(8); PG8_WAIT_L(0); PG8_BAR; PG8_MMA(0, 0, At, B0); PG8_MMA(0, 1, At, B1); PG8_BAR; PG8_SCHED;
            PG8_LDA(At, 0, 1); PG8_STAGE(PG8_SB(0, 0), b2, voffB); PG8_STAGE(PG8_SB(0, 1), b2 + hstep, voffB); PG8_STAGE(PG8_SA(0, 0), a2, voffA);
            PG8_WAIT_V(8); PG8_WAIT_L(0); PG8_BAR; PG8_MMA(1, 0, At, B0); PG8_MMA(1, 1, At, B1); PG8_BAR; PG8_SCHED;
            PG8_LDB(B0, 1, 0); PG8_LDB(B1, 1, 1); PG8_SCHED; PG8_LDA(At, 1, 0); PG8_STAGE(PG8_SA(0, 1), a2 + hstep, voffA);
            PG8_WAIT_V(8); PG8_WAIT_L(0); PG8_BAR; PG8_MMA(0, 0, At, B0); PG8_MMA(0, 1, At, B1); PG8_BAR; PG8_SCHED;
            PG8_LDA(At, 1, 1); PG8_STAGE(PG8_SB(1, 0), b3, voffB); PG8_STAGE(PG8_SB(1, 1), b3 + hstep, voffB); PG8_STAGE(PG8_SA(1, 0), a3, voffA);
            PG8_WAIT_V(8); PG8_WAIT_L(0); PG8_BAR; PG8_MMA(1, 0, At, B0); PG8_MMA(1, 1, At, B1); PG8_BAR; PG8_SCHED;
            } else {
            PG8_LDB(B0, 0, 0); PG8_SCHED; PG8_LDA(At, 0, 0); PG8_STAGE(PG8_SA(1, 1), a1 + hstep, voffA);
            PG8_WAIT_L(8); PG8_BAR; PG8_WAIT_L(0); PG8_MMA(0, 0, At, B0); PG8_BAR; PG8_SCHED;
            PG8_LDB(B1, 0, 1); PG8_STAGE(PG8_SB(0, 0), b2, voffB);
            PG8_BAR; PG8_WAIT_L(0); PG8_MMA(0, 1, At, B1); PG8_BAR;
            PG8_LDA(At, 0, 1); PG8_STAGE(PG8_SA(0, 0), a2, voffA);
            PG8_BAR; PG8_WAIT_L(0); PG8_MMA(1, 0, At, B0); PG8_BAR; PG8_SCHED;
            PG8_STAGE(PG8_SB(0, 1), b2 + hstep, voffB);
            PG8_WAIT_V(6); PG8_BAR; PG8_MMA(1, 1, At, B1); PG8_BAR;
            PG8_LDB(B0, 1, 0); PG8_SCHED; PG8_LDA(At, 1, 0); PG8_STAGE(PG8_SA(0, 1), a2 + hstep, voffA);
            PG8_WAIT_L(8); PG8_BAR; PG8_WAIT_L(0); PG8_MMA(0, 0, At, B0); PG8_BAR; PG8_SCHED;
            PG8_LDB(B1, 1, 1); PG8_STAGE(PG8_SB(1, 0), b3, voffB);
            PG8_BAR; PG8_WAIT_L(0); PG8_MMA(0, 1, At, B1); PG8_BAR;
            PG8_LDA(At, 1, 1); PG8_STAGE(PG8_SA(1, 0), a3, voffA);
            PG8_BAR; PG8_WAIT_L(0); PG8_MMA(1, 0, At, B0); PG8_BAR; PG8_SCHED;
            PG8_STAGE(PG8_SB(1, 1), b3 + hstep, voffB);
            PG8_WAIT_V(6); PG8_BAR; PG8_MMA(1, 1, At, B1); PG8_BAR;
            }
        }
        if constexpr (ALIGN_EPI) { if (wr == 0) PG8_BAR; }
        E(acc, cur, wr, wc, fr, fq); S.done(cur);
        if (!has_next) break;
#pragma unroll
        for (int a = 0; a < 2; ++a)
#pragma unroll
            for (int b = 0; b < 2; ++b)
#pragma unroll
                for (int m = 0; m < 4; ++m)
#pragma unroll
                    for (int n = 0; n < 2; ++n) acc[a][b][m][n] = (f32x4){0.f, 0.f, 0.f, 0.f};
        cur = nxt; cA = nA; cB = nB; ++ui;
        if constexpr (ALIGN_EPI) { if (wr == 1) PG8_BAR; }
    }
    PG8_WAIT_V(0);
    if constexpr (!ALIGN_EPI) { if (wr == 0) PG8_BAR; }
    PG8_BAR;
#undef PG8_SA
#undef PG8_SB
#undef PG8_STAGE
#undef PG8_LDA
#undef PG8_LDB
#undef PG8_MMA
#undef PG8_WAIT_V
#undef PG8_WAIT_L
#undef PG8_BAR
#undef PG8_SCHED
}
}

#ifndef PG8_SP2
#define PG8_SP2 true
#endif
#ifndef PG8_ALIGN
#define PG8_ALIGN true
#endif

constexpr int NWAVES = 8;
constexpr int N_LAUNCHES = MK_N_LAUNCHES;
constexpr int N_PHASES = 10;
constexpr int D = 1024, NB = 8, SEQ = 2048, MP = NB * SEQ  , NS = 128, MROWS = MP + NS  , MT = 65 * 256  ;
constexpr int WA = 256, WB = 384, WC = 384, INC = 3200, NIN = 13 * 256  , PLED = 256, TW = 2048  ;
constexpr float EPS = 1e-6f;
constexpr int T_VA = 0, T_SZA = 256, T_UB = 512, T_SZB = 896, T_UC = 1280, T_BZ = 1664;
constexpr size_t O_Y = 0, O_POOLP = (size_t)MROWS * D, O_POOLS = O_POOLP + 2 * 8 * 15 * 256, O_CONVP = O_POOLS + 2 * 128 * 15 * 256, O_CONVS = O_CONVP + 2 * 8 * 30 * 384,
                 O_SCP = O_CONVS + 2 * 128 * 30 * 384, O_SCS = O_SCP + 2 * 8 * 2 * 384, O_END = O_SCS + 2 * 128 * 2 * 384;
constexpr size_t MiB = 1u << 20;
constexpr size_t WS_CTL = 0, CTL_ZERO_BYTES = 1 * MiB;
constexpr size_t WS_WIN = 2 * MiB, WIN_STRIDE = 7 * MiB;
constexpr size_t WS_WOUT = 16 * MiB, WS_WG = 20 * MiB, W1K_STRIDE = 2 * MiB;
constexpr size_t WS_WPLE = 24 * MiB, WPLE_STRIDE = MiB / 2;
constexpr size_t WS_SSQ = 25 * MiB;
constexpr size_t WS_PSB = 27 * MiB, WS_PSA = WS_PSB + 2 * 128 * 384 * 4, WS_PSC = WS_PSA + 2 * 128 * 256 * 4;
constexpr size_t WS_PE = 28 * MiB, PE_STRIDE = 9 * MiB;
constexpr size_t WS_XBA = 46 * MiB, WS_XBB = 79 * MiB, WS_Y = 112 * MiB, WS_PLEO = 145 * MiB;
constexpr size_t WS_T = 178 * MiB;
constexpr size_t WS_END = 243 * MiB;
static_assert((size_t)NIN * D * 2 <= WIN_STRIDE && (size_t)MT * 16 * 4 <= 3 * MiB && (size_t)MT * 256 * 2 <= PE_STRIDE && (size_t)MT * D * 2 <= 33 * MiB && (size_t)MT * TW * 2 <= 65 * MiB, "ws map");
constexpr int CW_BAR = 4096;
constexpr int RING_OFF = 0, RING_BYTES = 131072;
constexpr int LDS_BYTES = 147456;
constexpr int LDSCTL_OFF = LDS_BYTES - 256, MISC_OFF = LDSCTL_OFF;

#define GAS __attribute__((address_space(1)))
#define LAS __attribute__((address_space(3)))
typedef unsigned short bf16;
typedef unsigned v4u __attribute__((ext_vector_type(4)));
typedef unsigned v2u __attribute__((ext_vector_type(2)));
typedef float f32x4 __attribute__((ext_vector_type(4)));
typedef float f32x2 __attribute__((ext_vector_type(2)));
typedef GAS unsigned gu32;
#define RLX_AGENT __ATOMIC_RELAXED, __HIP_MEMORY_SCOPE_AGENT
#define LDS_WAIT() asm volatile("s_waitcnt lgkmcnt(0)" ::: "memory")
#define VM_WAIT() asm volatile("s_waitcnt vmcnt(0)" ::: "memory")
__device__ __forceinline__ unsigned f2bf(float f) { unsigned u = __builtin_bit_cast(unsigned, f); return (u + 0x7fffu + ((u >> 16) & 1u)) >> 16; }
__device__ __forceinline__ unsigned pk2(float lo, float hi) { return f2bf(lo) | (f2bf(hi) << 16); }
__device__ __forceinline__ float bf_lo(unsigned u) { return __builtin_bit_cast(float, u << 16); }
__device__ __forceinline__ float bf_hi(unsigned u) { return __builtin_bit_cast(float, u & 0xffff0000u); }
__device__ __forceinline__ float sigmoidf_(float x) { return __builtin_amdgcn_rcpf(1.0f + __expf(-x)); }
__device__ __forceinline__ float siluf_(float x) { return x * sigmoidf_(x); }

#define XB_TMO      128
#define XB_XCNT(j)  (256  + 64 * (j))
#define XB_XSUB(j)  (1280 + 64 * (j))
#define XB_XGEN(j)  (2304 + 64 * (j))
#define XB_TOP      3328
#define XB_TOPGEN   3392
#define XCD_BAR_WORDS 3456
#define XB_SPIN_CAP (1u << 18)
__device__ __forceinline__ unsigned xb_ld(unsigned* p)              { return __hip_atomic_load(p, __ATOMIC_RELAXED, __HIP_MEMORY_SCOPE_AGENT); }
__device__ __forceinline__ unsigned xb_add(unsigned* p, unsigned v) { return __hip_atomic_fetch_add(p, v, __ATOMIC_RELAXED, __HIP_MEMORY_SCOPE_AGENT); }
__device__ __forceinline__ unsigned xb_xcc_id() { return (unsigned)__builtin_amdgcn_s_getreg((3 << 11) | 20) & 0xFu; }
#define XB_SPIN(cond, bar) do { unsigned _sp = 0; while (cond) { __builtin_amdgcn_s_sleep(1); \
    if ((++_sp & 255u) == 0u) { if (xb_ld(&(bar)[XB_TMO])) break; if (_sp > XB_SPIN_CAP) { atomicAdd(&(bar)[XB_TMO], 1u); break; } } } } while (0)
struct XcdBarrier { unsigned* bar; unsigned x; volatile LAS unsigned* st; };
__device__ __forceinline__ XcdBarrier xcd_barrier_post(unsigned* bar, volatile LAS unsigned* st) {
    XcdBarrier b; b.bar = bar; b.x = xb_xcc_id(); b.st = st;
    if (threadIdx.x == 0) (void)xb_add(&bar[XB_XCNT(b.x)], 1u);
    return b;
}
__device__ __forceinline__ void xcd_barrier_complete(unsigned* bar, unsigned x, unsigned& nloc, unsigned& nx) {
    const unsigned G = gridDim.x * gridDim.y * gridDim.z;
    unsigned sum, cnt, mine, sp = 0u;
    for (;;) {
        sum = 0u; cnt = 0u; mine = 0u;
#pragma unroll
        for (unsigned j = 0; j < 16; ++j) { const unsigned c = xb_ld(&bar[XB_XCNT(j)]); sum += c; cnt += (c > 0u) ? 1u : 0u; mine = (j == x) ? c : mine; }
        if (sum == G) break;
        __builtin_amdgcn_s_sleep(1);
        if ((++sp & 255u) == 0u) { if (xb_ld(&bar[XB_TMO])) break; if (sp > XB_SPIN_CAP) { atomicAdd(&bar[XB_TMO], 1u); break; } }
    }
    nloc = mine > 0u ? mine : 1u; nx = cnt > 0u ? cnt : 1u;
}
__device__ __forceinline__ void xcd_barrier(const XcdBarrier& b) {
    asm volatile("s_waitcnt vmcnt(0)" ::: "memory");
    __syncthreads();
    if (threadIdx.x == 0) {
        unsigned* bar = b.bar;
        __builtin_amdgcn_s_waitcnt(0);
        unsigned nloc = b.st[0], nx = b.st[1];
        if (nloc == 0u) { xcd_barrier_complete(bar, b.x, nloc, nx); b.st[0] = nloc; b.st[1] = nx; }
        const unsigned old = xb_add(&bar[XB_XSUB(b.x)], 1u);
        const unsigned gen = old / nloc;
        if (old + 1u == (gen + 1u) * nloc) {
            __builtin_amdgcn_fence(__ATOMIC_RELEASE, "agent");
            asm volatile("s_waitcnt vmcnt(0)" ::: "memory");
            const unsigned og = xb_add(&bar[XB_TOP], 1u);
            const unsigned tg = og / nx;
            if (og + 1u == (tg + 1u) * nx) xb_add(&bar[XB_TOPGEN], 1u);
            else XB_SPIN(xb_ld(&bar[XB_TOPGEN]) == tg, bar);
            __builtin_amdgcn_fence(__ATOMIC_ACQUIRE, "agent");
            xb_add(&bar[XB_XGEN(b.x)], 1u);
            asm volatile("s_waitcnt vmcnt(0)" ::: "memory");
        } else {
            XB_SPIN(xb_ld(&bar[XB_XGEN(b.x)]) == gen, bar);
            __builtin_amdgcn_fence(__ATOMIC_ACQUIRE, "agent");
            asm volatile("s_waitcnt vmcnt(0)" ::: "memory");
        }
    }
    __syncthreads();
}

struct Args { const float* in[20]; float* out; unsigned char* ws; int ph_lo, ph_hi, li, pad; };
enum { I_XP = 0, I_XS, I_SPOOL, I_SCONV, I_SSCONV, I_PP, I_PS, I_NORMG, I_WIN, I_WMIX, I_PSCALE, I_CBW, I_CBB, I_LNG, I_LNB, I_SCW, I_WOUT, I_WPLE, I_WGATE, I_FNG };
struct Frame {
    LAS unsigned char* lds;
    volatile LAS unsigned* MISC;
    gu32* ctl;
    int tid, lane, wave;
    int vcu, G;
    float* out;
    unsigned char* ws;
};
__device__ __forceinline__ bf16* ws_bf(const Frame& F, size_t off) { return (bf16*)(F.ws + off); }

__device__ __forceinline__ float wave_sum(float v) {
#pragma unroll
    for (int o = 1; o < 64; o <<= 1) v += __shfl_xor(v, o);
    return v;
}

using pg8::Unit; using pg8::cvt_pk_bf16;
__device__ __forceinline__ v4u pack8(const f32x4 a, const f32x4 b) { v4u w; w.x = cvt_pk_bf16(a[0], a[1]); w.y = cvt_pk_bf16(a[2], a[3]); w.z = cvt_pk_bf16(b[0], b[1]); w.w = cvt_pk_bf16(b[2], b[3]); return w; }
__device__ __forceinline__ f32x4 sig4(const f32x4 v) { return (f32x4){sigmoidf_(v[0]), sigmoidf_(v[1]), sigmoidf_(v[2]), sigmoidf_(v[3])}; }
__device__ __forceinline__ f32x4 silu4(const f32x4 v) { return v * sig4(v); }

__device__ __forceinline__ float* state_ptr(float* out, int layer, int row, int H, int C, size_t offP, size_t offS) {
    if (row < MP) { const int b = row >> 11, t = row & 2047, j = t - (SEQ - H); if (j < 0) return nullptr; return out + offP + ((size_t)(layer * NB + b) * H + j) * C; }
    const int s = row - MP; if (s >= NS) return nullptr; return out + offS + ((size_t)(layer * NS + s) * H + (H - 1)) * C;
}

struct EpiIn {
    static constexpr bool PERM = true, AFTER_DRAIN = false;
    bf16* T; const float* ssq; float* out; int layer;
    __device__ __forceinline__ void operator()(const f32x4 (&acc)[2][2][4][2], const Unit& u, int wr, int wc, int fr, int fq) const {
        const int pn = u.pn, pm = u.pm, cl = wc * 32 + 8 * fq, rowb = pm * 256 + wr * 64 + fr;
        const bool has_state = (pm == 64) || ((pm & 7) == 7);
        int ty, oc0, oc1 = 0, sc0 = 0;
        if (pn < 3) { ty = 0; oc0 = T_UB + 128 * pn; sc0 = 128 * pn; }
        else if (pn < 6) { ty = 1; oc0 = T_UC + 128 * (pn - 3); sc0 = 128 * (pn - 3); }
        else if (pn < 9) { ty = 2; oc0 = T_BZ + 128 * (pn - 6); }
        else if (pn == 9) { ty = 3; oc0 = T_VA; oc1 = T_VA + 128; }
        else if (pn == 10) { ty = 4; oc0 = T_SZA; oc1 = T_SZA + 128; }
        else if (pn == 11) { ty = 4; oc0 = T_SZB; oc1 = T_SZB + 128; }
        else { ty = 5; oc0 = T_SZB + 256; }
#pragma unroll
        for (int ai = 0; ai < 2; ++ai)
#pragma unroll
            for (int m = 0; m < 4; ++m) {
                const int row = rowb + ai * 128 + m * 16;
                const f32x4* sp = (const f32x4*)(ssq + (size_t)row * 16);
                const f32x4 s0 = sp[0], s1 = sp[1], s2 = sp[2], s3 = sp[3];
                const float ss = ((s0[0] + s0[1]) + (s0[2] + s0[3])) + ((s1[0] + s1[1]) + (s1[2] + s1[3])) + ((s2[0] + s2[1]) + (s2[2] + s2[3])) + ((s3[0] + s3[1]) + (s3[2] + s3[3]));
                const float rs = __builtin_amdgcn_rsqf(ss * (1.0f / D) + EPS);
                const f32x4 h0a = acc[ai][0][m][0] * rs, h0b = acc[ai][0][m][1] * rs, h1a = acc[ai][1][m][0] * rs, h1b = acc[ai][1][m][1] * rs;
                bf16* trow = T + (size_t)row * TW + cl;
                if (ty == 0 || ty == 1 || ty == 2) {
                    f32x4 oa, ob;
                    if (ty == 0) { oa = h0a * sig4(h1a); ob = h0b * sig4(h1b); }
                    else if (ty == 1) { oa = h0a * h1a; ob = h0b * h1b; }
                    else { oa = h0a * silu4(h1a); ob = h0b * silu4(h1b); }
                    *(v4u*)(trow + oc0) = pack8(oa, ob);
                    if (has_state && ty != 2) {
                        float* p = (ty == 0) ? state_ptr(out, layer, row, 30, 384, O_CONVP, O_CONVS) : state_ptr(out, layer, row, 2, 384, O_SCP, O_SCS);
                        if (p) { *(f32x4*)(p + sc0 + cl) = oa; *(f32x4*)(p + sc0 + cl + 4) = ob; }
                    }
                } else if (ty == 3) {
                    *(v4u*)(trow + oc0) = pack8(h0a, h0b); *(v4u*)(trow + oc1) = pack8(h1a, h1b);
                    if (has_state) { float* p = state_ptr(out, layer, row, 15, 256, O_POOLP, O_POOLS);
                        if (p) { *(f32x4*)(p + cl) = h0a; *(f32x4*)(p + cl + 4) = h0b; *(f32x4*)(p + 128 + cl) = h1a; *(f32x4*)(p + 128 + cl + 4) = h1b; } }
                } else if (ty == 4) {
                    *(v4u*)(trow + oc0) = pack8(silu4(h0a), silu4(h0b)); *(v4u*)(trow + oc1) = pack8(silu4(h1a), silu4(h1b));
                } else {
                    *(v4u*)(trow + oc0) = pack8(silu4(h0a), silu4(h0b));
                }
            }
    }
};

struct EpiOut {
    static constexpr bool PERM = true, AFTER_DRAIN = false;
    const float* xp; const float* xs; float* xres; bf16* xb; int layer;
    __device__ __forceinline__ void operator()(const f32x4 (&acc)[2][2][4][2], const Unit& u, int wr, int wc, int fr, int fq) const {
        const int cl = u.pn * 256 + wc * 32 + 8 * fq, rowb = u.pm * 256 + wr * 64 + fr;
#pragma unroll
        for (int ai = 0; ai < 2; ++ai)
#pragma unroll
            for (int m = 0; m < 4; ++m) {
                const int row = rowb + ai * 128 + m * 16;
                if (row < MROWS) {
                    const float* rin = (layer == 0) ? (row < MP ? xp + (size_t)row * D : xs + (size_t)(row - MP) * D) : xres + (size_t)row * D;
#pragma unroll
                    for (int bj = 0; bj < 2; ++bj) { const int col = cl + bj * 128;
                        const f32x4 a = *(const f32x4*)(rin + col), b = *(const f32x4*)(rin + col + 4);
                        const f32x4 v0 = acc[ai][bj][m][0] + a, v1 = acc[ai][bj][m][1] + b;
                        float* o = xres + (size_t)row * D + col; *(f32x4*)o = v0; *(f32x4*)(o + 4) = v1;
                        *(v4u*)(xb + (size_t)row * D + col) = pack8(v0, v1); }
                }
            }
    }
};

struct EpiPlain {
    static constexpr bool PERM = true, AFTER_DRAIN = false;
    bf16* O;
    __device__ __forceinline__ void operator()(const f32x4 (&acc)[2][2][4][2], const Unit& u, int wr, int wc, int fr, int fq) const {
        const int cl = u.pn * 256 + wc * 32 + 8 * fq, rowb = u.pm * 256 + wr * 64 + fr;
#pragma unroll
        for (int ai = 0; ai < 2; ++ai)
#pragma unroll
            for (int m = 0; m < 4; ++m) { const int row = rowb + ai * 128 + m * 16;
#pragma unroll
                for (int bj = 0; bj < 2; ++bj) *(v4u*)(O + (size_t)row * D + cl + bj * 128) = pack8(acc[ai][bj][m][0], acc[ai][bj][m][1]); }
    }
};

struct EpiGate {
    static constexpr bool PERM = true, AFTER_DRAIN = false;
    float* xres; const bf16* ple; bf16* xb; float* ssq;
    __device__ __forceinline__ void operator()(const f32x4 (&acc)[2][2][4][2], const Unit& u, int wr, int wc, int fr, int fq) const {
        const int cl = u.pn * 256 + wc * 32 + 8 * fq, rowb = u.pm * 256 + wr * 64 + fr;
#pragma unroll
        for (int ai = 0; ai < 2; ++ai)
#pragma unroll
            for (int m = 0; m < 4; ++m) {
                const int row = rowb + ai * 128 + m * 16;
                const bool valid = row < MROWS;
                float ss = 0.f;
#pragma unroll
                for (int bj = 0; bj < 2; ++bj) { const int col = cl + bj * 128;
                    float* o = xres + (size_t)row * D + col;
                    f32x4 a = (f32x4){0.f, 0.f, 0.f, 0.f}, b = a;
                    if (valid) { a = *(const f32x4*)o; b = *(const f32x4*)(o + 4); }
                    const v4u pw = *(const v4u*)(ple + (size_t)row * D + col);
                    const f32x4 pa = (f32x4){bf_lo(pw.x), bf_hi(pw.x), bf_lo(pw.y), bf_hi(pw.y)}, pb = (f32x4){bf_lo(pw.z), bf_hi(pw.z), bf_lo(pw.w), bf_hi(pw.w)};
                    const f32x4 v0 = a + pa * sig4(acc[ai][bj][m][0]), v1 = b + pb * sig4(acc[ai][bj][m][1]);
                    ss += (v0[0] * v0[0] + v0[1] * v0[1]) + (v0[2] * v0[2] + v0[3] * v0[3]) + (v1[0] * v1[0] + v1[1] * v1[1]) + (v1[2] * v1[2] + v1[3] * v1[3]);
                    if (valid) { *(f32x4*)o = v0; *(f32x4*)(o + 4) = v1; *(v4u*)(xb + (size_t)row * D + col) = pack8(v0, v1); }
                }
                ss += __shfl_xor(ss, 16); ss += __shfl_xor(ss, 32);
                if (fq == 0) ssq[(size_t)row * 16 + u.pn * 4 + wc] = ss;
            }
    }
};

__device__ __forceinline__ int in_half_src(int hh) {
    const int t = hh >> 1, h = hh & 1;
    if (t < 3) return (h ? 896 : 512) + 128 * t;
    if (t < 6) return (h ? 1664 : 2432) + 128 * (t - 3);
    if (t < 9) return (h ? 2816 : 2048) + 128 * (t - 6);
    if (t == 9) return h ? 128 : 0;
    if (t == 10) return h ? 384 : 256;
    if (t == 11) return h ? 1408 : 1280;
    return 1536;
}
__device__ __forceinline__ void p0_transpose_item(const float* W, int K, int N, int src_n0, bf16* WT, int dst_row0, const float* gscale, LAS float* scr, int k0, int lane) {
#pragma unroll 8
    for (int i = 0; i < 32; ++i) { const int kk = 2 * i + (lane >> 5); float w = W[(size_t)(k0 + kk) * N + src_n0 + (lane & 31)]; if (gscale) w *= gscale[k0 + kk]; scr[kk * 33 + (lane & 31)] = w; }
    LDS_WAIT(); asm volatile("" ::: "memory");
    const int c = lane & 7;
#pragma unroll
    for (int j = 0; j < 4; ++j) { const int n = (lane >> 3) + 8 * j; const LAS float* s = scr + (8 * c) * 33 + n;
        v4u o; o.x = pk2(s[0 * 33], s[1 * 33]); o.y = pk2(s[2 * 33], s[3 * 33]); o.z = pk2(s[4 * 33], s[5 * 33]); o.w = pk2(s[6 * 33], s[7 * 33]);
        *(GAS v4u*)(WT + (size_t)(dst_row0 + n) * K + k0 + 8 * c) = o; }
    LDS_WAIT(); asm volatile("" ::: "memory");
}
__device__ __forceinline__ void p0_prologue(Frame& F, const Args& A) {
    LAS float* scr = (LAS float*)(F.lds + RING_OFF + F.wave * 16384);
    const int gw = F.vcu * NWAVES + F.wave, NGW = F.G * NWAVES;
    constexpr int I_IN = 16 * 104, I_SQ = 16 * 32, I_PLE = 4 * 32, I_L = I_IN + 2 * I_SQ + I_PLE, NITEMS = 2 * I_L;
    for (int it = gw; it < NITEMS; it += NGW) {
        const int l = it / I_L; int r = it % I_L;
        if (r < I_IN) { const int kb = r / 104, nb = r % 104; p0_transpose_item(A.in[I_WIN] + (size_t)l * D * INC, D, INC, in_half_src(nb >> 2) + 32 * (nb & 3), ws_bf(F, WS_WIN + l * WIN_STRIDE), 32 * nb, A.in[I_NORMG] + l * D, scr, 64 * kb, F.lane); continue; } r -= I_IN;
        if (r < I_SQ) { const int kb = r / 32, nb = r % 32; p0_transpose_item(A.in[I_WOUT] + (size_t)l * D * D, D, D, 32 * nb, ws_bf(F, WS_WOUT + l * W1K_STRIDE), 32 * nb, nullptr, scr, 64 * kb, F.lane); continue; } r -= I_SQ;
        if (r < I_SQ) { const int kb = r / 32, nb = r % 32; p0_transpose_item(A.in[I_WGATE] + (size_t)l * D * D, D, D, 32 * nb, ws_bf(F, WS_WG + l * W1K_STRIDE), 32 * nb, nullptr, scr, 64 * kb, F.lane); continue; } r -= I_SQ;
        { const int kb = r / 32, nb = r % 32; p0_transpose_item(A.in[I_WPLE] + (size_t)l * PLED * D, PLED, D, 32 * nb, ws_bf(F, WS_WPLE + l * WPLE_STRIDE), 32 * nb, nullptr, scr, 64 * kb, F.lane); }
    }
    bf16* XB = ws_bf(F, WS_XBA); float* SSQ = (float*)(F.ws + WS_SSQ);
    for (int m = gw; m < MROWS; m += NGW) {
        const float* xrow = m < MP ? A.in[I_XP] + (size_t)m * D : A.in[I_XS] + (size_t)(m - MP) * D;
        const GAS f32x4* xr = (const GAS f32x4*)xrow + F.lane;
        f32x4 v[4]; float s = 0.f;
#pragma unroll
        for (int j = 0; j < 4; ++j) { v[j] = xr[64 * j]; s += (v[j].x * v[j].x + v[j].y * v[j].y) + (v[j].z * v[j].z + v[j].w * v[j].w); }
        s = wave_sum(s);
        GAS v2u* o8 = (GAS v2u*)(XB + (size_t)m * D) + F.lane;
#pragma unroll
        for (int j = 0; j < 4; ++j) o8[64 * j] = (v2u){pk2(v[j].x, v[j].y), pk2(v[j].z, v[j].w)};
        if (F.lane < 16) SSQ[(size_t)m * 16 + F.lane] = (F.lane == 0) ? s : 0.f;
    }
    for (int it = gw; it < 2 * MROWS; it += NGW) {
        const int l = it / MROWS, m = it % MROWS;
        const float* prow = m < MP ? A.in[I_PP] + ((size_t)l * MP + m) * PLED : A.in[I_PS] + ((size_t)l * NS + (m - MP)) * PLED;
        const f32x4 v = ((const GAS f32x4*)prow)[F.lane];
        ((GAS v2u*)(ws_bf(F, WS_PE + l * PE_STRIDE) + (size_t)m * PLED))[F.lane] = (v2u){pk2(v.x, v.y), pk2(v.z, v.w)};
    }
    { const int gt0 = F.vcu * (NWAVES * 64) + F.tid, NGT0 = F.G * NWAVES * 64;
      for (int i = gt0; i < 2 * NS * (192 + 128 + 192); i += NGT0) {
          if (i < 2 * NS * 192) { const int ls = i / 192, ch = 2 * (i % 192), l = ls / NS;
              const float* st = A.in[I_SCONV] + (size_t)ls * 30 * WB + ch; const float* cw = A.in[I_CBW] + (size_t)l * 31 * WB + ch;
              f32x2 a = *(const GAS f32x2*)(A.in[I_CBB] + l * WB + ch);
#pragma unroll 10
              for (int k = 0; k < 30; ++k) a += *(const GAS f32x2*)(cw + k * WB) * *(const GAS f32x2*)(st + k * WB);
              *(GAS f32x2*)((float*)(F.ws + WS_PSB) + (size_t)ls * WB + ch) = a; }
          else if (i < 2 * NS * 320) { const int i2 = i - 2 * NS * 192, ls = i2 / 128, cp = i2 % 128, ch = 2 * cp, w = 2 << (cp >> 5);
              const float* st = A.in[I_SPOOL] + (size_t)ls * 15 * WA + ch; f32x2 a = (f32x2){0.f, 0.f};
              for (int j = 1; j < w; ++j) a += *(const GAS f32x2*)(st + (15 - j) * WA);
              *(GAS f32x2*)((float*)(F.ws + WS_PSA) + (size_t)ls * WA + ch) = a; }
          else { const int i2 = i - 2 * NS * 320, ls = i2 / 192, ch = 2 * (i2 % 192), l = ls / NS;
              const float* st = A.in[I_SSCONV] + (size_t)ls * 2 * WC + ch; const float* w = A.in[I_SCW] + (size_t)l * 3 * WC + ch;
              *(GAS f32x2*)((float*)(F.ws + WS_PSC) + (size_t)ls * WC + ch) = *(const GAS f32x2*)w * *(const GAS f32x2*)st + *(const GAS f32x2*)(w + WC) * *(const GAS f32x2*)(st + WC); }
      } }
    const int gt = F.vcu * (NWAVES * 64) + F.tid, NGT = F.G * NWAVES * 64;
    for (int i = gt; i < 2 * NS * 14 * 64; i += NGT) { const int ls = i / (14 * 64), r = i % (14 * 64);
        ((GAS f32x4*)(F.out + O_POOLS + (size_t)ls * 15 * 256))[r] = ((const GAS f32x4*)(A.in[I_SPOOL] + (size_t)ls * 15 * 256 + 256))[r]; }
    for (int i = gt; i < 2 * NS * 29 * 96; i += NGT) { const int ls = i / (29 * 96), r = i % (29 * 96);
        ((GAS f32x4*)(F.out + O_CONVS + (size_t)ls * 30 * 384))[r] = ((const GAS f32x4*)(A.in[I_SCONV] + (size_t)ls * 30 * 384 + 384))[r]; }
    for (int i = gt; i < 2 * NS * 96; i += NGT) { const int ls = i / 96, r = i % 96;
        ((GAS f32x4*)(F.out + O_SCS + (size_t)ls * 2 * 384))[r] = ((const GAS f32x4*)(A.in[I_SSCONV] + (size_t)ls * 2 * 384 + 384))[r]; }
}

__device__ __forceinline__ int opaque0() { int z; asm volatile("s_mov_b32 %0, 0" : "=s"(z)); return z; }
__device__ __forceinline__ f32x2 ldbf2(const bf16* p) { const unsigned u = *(const GAS unsigned*)p; return (f32x2){bf_lo(u), bf_hi(u)}; }
typedef short bf16x8_t __attribute__((ext_vector_type(8)));
constexpr int MX_CWS = 0, MX_UBS = 47616, MX_VAS = 82944, MX_CB = 98816, MX_PLB = 123392, MX_END = 131840, PLB_LD = 264;
constexpr int MX_NCH_UB = 46 * 48, MX_NCH = MX_NCH_UB + 31 * 32;
static_assert(MX_END <= LDSCTL_OFF, "mixer LDS map");
__device__ __forceinline__ void mixer_phase(Frame& F, const Args& A, int layer) {
    LAS float* CWS = (LAS float*)(F.lds + MX_CWS);
    LAS unsigned* UBS = (LAS unsigned*)(F.lds + MX_UBS);
    LAS unsigned* VAS = (LAS unsigned*)(F.lds + MX_VAS);
    LAS float* CB = (LAS float*)(F.lds + MX_CB);
    LAS bf16* PLB = (LAS bf16*)(F.lds + MX_PLB);
    const bf16* T = ws_bf(F, WS_T); bf16* Y = ws_bf(F, WS_Y);
    const int tid = F.tid + opaque0(), lane = tid & 63, wave = F.wave, fr = lane & 15, fq = lane >> 4;
    { const GAS f32x4* cwg = (const GAS f32x4*)(A.in[I_CBW] + (size_t)layer * 31 * WB);
      for (int i = tid; i < 31 * 96; i += 512) ((LAS f32x4*)CWS)[i] = cwg[i]; }
    bf16x8_t wf[2][2];
    { const float* wm = A.in[I_WMIX] + (size_t)layer * 16384 + (size_t)(wave >> 1) * 4096;
#pragma unroll
      for (int a = 0; a < 2; ++a)
#pragma unroll
          for (int ks = 0; ks < 2; ++ks) { const float* p = wm + (32 * ks + 8 * fq) * 64 + 16 * (2 * (wave & 1) + a) + fr;
              v4u w; w.x = pk2(p[0], p[64]); w.y = pk2(p[128], p[192]); w.z = pk2(p[256], p[320]); w.w = pk2(p[384], p[448]); wf[a][ks] = __builtin_bit_cast(bf16x8_t, w); } }
    const float* cbias = A.in[I_CBB] + layer * WB; const float* lg = A.in[I_LNG] + layer * WB; const float* lb = A.in[I_LNB] + layer * WB;
    const float* sw = A.in[I_SCW] + layer * 3 * WC; const float* psc = A.in[I_PSCALE] + layer * WA;
    const float* PSB = (const float*)(F.ws + WS_PSB) + (size_t)layer * NS * WB; const float* PSA = (const float*)(F.ws + WS_PSA) + (size_t)layer * NS * WA; const float* PSC = (const float*)(F.ws + WS_PSC) + (size_t)layer * NS * WC;
    v4u pf[7];
#define MX_PREFETCH(uu) do { const int r0_ = (uu) * 16, t0_ = r0_ & 2047; _Pragma("unroll") for (int i_ = 0; i_ < 7; ++i_) { const int c_ = tid + 512 * i_; v4u v_ = (v4u){0u, 0u, 0u, 0u}; \
        if (c_ < MX_NCH_UB) { const int j_ = c_ / 48, cc_ = c_ % 48; if (t0_ - 30 + j_ >= 0) v_ = *(const GAS v4u*)(T + (size_t)(r0_ - 30 + j_) * TW + T_UB + cc_ * 8); } \
        else if (c_ < MX_NCH) { const int c2_ = c_ - MX_NCH_UB, j_ = c2_ >> 5, cc_ = c2_ & 31; if (t0_ - 15 + j_ >= 0) v_ = *(const GAS v4u*)(T + (size_t)(r0_ - 15 + j_) * TW + T_VA + cc_ * 8); } \
        pf[i_] = v_; } } while (0)
    int u = blockIdx.x;
    if (u < 1024) MX_PREFETCH(u);
    for (; u < 1032; u += gridDim.x) {
        const bool smp = u >= 1024;
        const int row0 = smp ? MP + (u - 1024) * 16 : u * 16;
        const int t0 = smp ? 0 : (row0 & 2047);
        __syncthreads();
        if (!smp) {
#pragma unroll
            for (int i = 0; i < 7; ++i) { const int c = tid + 512 * i;
                if (c < MX_NCH_UB) *(LAS v4u*)(UBS + 4 * c) = pf[i]; else if (c < MX_NCH) *(LAS v4u*)(VAS + 4 * (c - MX_NCH_UB)) = pf[i]; }
        }
        { const int un = u + gridDim.x; if (un < 1024) MX_PREFETCH(un); }
        __syncthreads();
        if (tid < 384) {
            const int tz = tid + opaque0(), cp = tz % 192, tb = tz / 192, ch = 2 * cp;
            if (!smp) {
                const f32x2 bias = *(const GAS f32x2*)(cbias + ch);
                const LAS unsigned* ub = UBS + (8 * tb) * 192 + cp;
                f32x2 in[38];
#pragma unroll
                for (int j = 0; j < 38; ++j) { const unsigned w = ub[j * 192]; in[j] = (f32x2){bf_lo(w), bf_hi(w)}; }
                f32x2 a[8];
#pragma unroll
                for (int i = 0; i < 8; ++i) a[i] = bias;
#pragma unroll
                for (int k = 0; k < 31; ++k) { const f32x2 w = *(const LAS f32x2*)(CWS + k * WB + ch);
#pragma unroll
                    for (int i = 0; i < 8; ++i) a[i] += w * in[i + k]; }
#pragma unroll
                for (int i = 0; i < 8; ++i) *(LAS f32x2*)(CB + (8 * tb + i) * WB + ch) = a[i];
            } else {
                const f32x2 w30 = *(const LAS f32x2*)(CWS + 30 * WB + ch);
#pragma unroll
                for (int i = 0; i < 8; ++i) { const int s = (u - 1024) * 16 + 8 * tb + i;
                    *(LAS f32x2*)(CB + (8 * tb + i) * WB + ch) = *(const GAS f32x2*)(PSB + (size_t)s * WB + ch) + w30 * ldbf2(T + (size_t)(MP + s) * TW + T_UB + ch); }
            }
        }
        { const int lz = lane + opaque0();
#pragma unroll
          for (int q = 0; q < 4; ++q) { const int wt = wave + 8 * q, g = wt & 3, tk = 2 * (wt >> 2) + (lz >> 5), cp = 32 * g + (lz & 31), w = 2 << g;
              f32x2 s, v;
              if (!smp) { const LAS unsigned* vr = VAS + (15 + tk) * 128 + cp; const unsigned x0 = vr[0]; v = (f32x2){bf_lo(x0), bf_hi(x0)}; s = v;
                  for (int j = 1; j < w; ++j) { const unsigned x = vr[-j * 128]; s += (f32x2){bf_lo(x), bf_hi(x)}; }
                  const int t = t0 + tk; s = s * (1.0f / (float)(w < t + 1 ? w : t + 1)); }
              else { const int sq = (u - 1024) * 16 + tk; v = ldbf2(T + (size_t)(MP + sq) * TW + T_VA + 2 * cp); s = (*(const GAS f32x2*)(PSA + (size_t)sq * WA + 2 * cp) + v) * (1.0f / (float)w); }
              s = s - v;
              *(LAS unsigned*)(PLB + tk * PLB_LD + 2 * cp) = pk2(s.x, s.y); } }
        __syncthreads();
        const int tze = tid + opaque0();
        unsigned eu0[6], eu1[6], eu2[6], ebz[6];
#pragma unroll
        for (int q = 0; q < 6; ++q) { const int task = tze + 512 * q, tk = task / 192, cp = task % 192, ch = 2 * cp, row = row0 + tk, t = t0 + tk;
            const bf16* p = T + (size_t)row * TW + T_UC + ch;
            eu0[q] = *(const GAS unsigned*)p; ebz[q] = *(const GAS unsigned*)(p + (T_BZ - T_UC));
            eu1[q] = (!smp && t >= 1) ? *(const GAS unsigned*)(p - TW) : 0u; eu2[q] = (!smp && t >= 2) ? *(const GAS unsigned*)(p - 2 * TW) : 0u; }
        { const int lz = lane + opaque0();
#pragma unroll
          for (int q = 0; q < 2; ++q) { const int tk = 2 * wave + q, row = row0 + tk;
            f32x2 x[3]; float s = 0.f;
#pragma unroll
            for (int j = 0; j < 3; ++j) { x[j] = *(LAS f32x2*)(CB + tk * WB + 128 * j + 2 * lz); s += x[j].x + x[j].y; }
            const float mean = wave_sum(s) * (1.0f / WB); float s2 = 0.f;
#pragma unroll
            for (int j = 0; j < 3; ++j) { x[j] = x[j] - mean; s2 += x[j].x * x[j].x + x[j].y * x[j].y; }
            const float rstd = __builtin_amdgcn_rsqf(wave_sum(s2) * (1.0f / WB) + EPS);
#pragma unroll
            for (int j = 0; j < 3; ++j) { const int ch = 128 * j + 2 * lz;
                const f32x2 g = *(const GAS f32x2*)(lg + ch), b = *(const GAS f32x2*)(lb + ch), z = ldbf2(T + (size_t)row * TW + T_SZB + ch);
                const f32x2 y = x[j] * rstd * g + b;
                *(GAS unsigned*)(Y + (size_t)row * D + WA + ch) = pk2(siluf_(y.x) * z.x, siluf_(y.y) * z.y); }
          } }
        { const int g = wave >> 1;
          const bf16x8_t p0 = *(const LAS bf16x8_t*)(PLB + fr * PLB_LD + 64 * g + 8 * fq), p1 = *(const LAS bf16x8_t*)(PLB + fr * PLB_LD + 64 * g + 32 + 8 * fq);
#pragma unroll
          for (int a = 0; a < 2; ++a) {
              f32x4 acc = (f32x4){0.f, 0.f, 0.f, 0.f};
              acc = __builtin_amdgcn_mfma_f32_16x16x32_bf16(wf[a][0], p0, acc, 0, 0, 0);
              acc = __builtin_amdgcn_mfma_f32_16x16x32_bf16(wf[a][1], p1, acc, 0, 0, 0);
              const int ch = 64 * g + 16 * (2 * (wave & 1) + a) + 4 * fq, row = row0 + fr;
              const f32x4 sc = *(const GAS f32x4*)(psc + ch); const v2u zz = *(const GAS v2u*)(T + (size_t)row * TW + T_SZA + ch);
              *(GAS v2u*)(Y + (size_t)row * D + ch) = (v2u){pk2(acc[0] * sc[0] * bf_lo(zz.x), acc[1] * sc[1] * bf_hi(zz.x)), pk2(acc[2] * sc[2] * bf_lo(zz.y), acc[3] * sc[3] * bf_hi(zz.y))}; } }
#pragma unroll
        for (int q = 0; q < 6; ++q) { const int task = tze + 512 * q, tk = task / 192, cp = task % 192, ch = 2 * cp, row = row0 + tk;
            const f32x2 w2 = *(const GAS f32x2*)(sw + 2 * WC + ch); f32x2 s = w2 * (f32x2){bf_lo(eu0[q]), bf_hi(eu0[q])};
            if (!smp) s += *(const GAS f32x2*)(sw + ch) * (f32x2){bf_lo(eu2[q]), bf_hi(eu2[q])} + *(const GAS f32x2*)(sw + WC + ch) * (f32x2){bf_lo(eu1[q]), bf_hi(eu1[q])};
            else s += *(const GAS f32x2*)(PSC + (size_t)(row - MP) * WC + ch);
            *(GAS unsigned*)(Y + (size_t)row * D + WA + WB + ch) = pk2(s.x * bf_lo(ebz[q]), s.y * bf_hi(ebz[q])); }
    }
#undef MX_PREFETCH
    __syncthreads();
}

template <int MODE, int KSTEPS  >
__device__ __forceinline__ void skinny_task(Frame& F, int task, const bf16* A, const bf16* Bt, int K, const float* xin, float* xres, bf16* ob, const bf16* ple, float* ssq) {
    const int tid = F.tid + opaque0(), lane = tid & 63, wave = F.wave, fr = lane & 15, fq = lane >> 4;
    const int rb = task >> 4, cb = task & 15;
    LAS float* P = (LAS float*)(F.lds + RING_OFF);
    const bf16* ap = A + (size_t)(rb * 16 + fr) * K + wave * (KSTEPS * 32) + 8 * fq;
    const bf16* bp = Bt + (size_t)(cb * 64 + fr) * K + wave * (KSTEPS * 32) + 8 * fq;
    bf16x8_t af[KSTEPS], bfr[4][KSTEPS];
#pragma unroll
    for (int ks = 0; ks < KSTEPS; ++ks) { af[ks] = *(const GAS bf16x8_t*)(ap + 32 * ks);
#pragma unroll
        for (int ct = 0; ct < 4; ++ct) bfr[ct][ks] = *(const GAS bf16x8_t*)(bp + (size_t)(16 * ct) * K + 32 * ks); }
    __syncthreads();
#pragma unroll
    for (int ct = 0; ct < 4; ++ct) { f32x4 acc = (f32x4){0.f, 0.f, 0.f, 0.f};
#pragma unroll
        for (int ks = 0; ks < KSTEPS; ++ks) acc = __builtin_amdgcn_mfma_f32_16x16x32_bf16(bfr[ct][ks], af[ks], acc, 0, 0, 0);
        *(LAS f32x4*)(P + (wave * 16 + fr) * 64 + 16 * ct + 4 * fq) = acc; }
    __syncthreads();
    const int r = tid >> 5, c2 = (tid & 31) * 2;
    f32x2 v = (f32x2){0.f, 0.f};
#pragma unroll
    for (int w = 0; w < 8; ++w) v += *(const LAS f32x2*)(P + (w * 16 + r) * 64 + c2);
    const int row = MP + rb * 16 + r, col = cb * 64 + c2;
    if (MODE == 0) { const f32x2 x = *(const GAS f32x2*)(xin + (size_t)(rb * 16 + r) * D + col); v += x;
        *(GAS f32x2*)(xres + (size_t)row * D + col) = v; *(GAS unsigned*)(ob + (size_t)row * D + col) = pk2(v.x, v.y); }
    else if (MODE == 1) { *(GAS unsigned*)(ob + (size_t)row * D + col) = pk2(v.x, v.y); }
    else { const f32x2 x = *(const GAS f32x2*)(xres + (size_t)row * D + col), p = ldbf2(ple + (size_t)row * D + col);
        v = x + p * (f32x2){sigmoidf_(v.x), sigmoidf_(v.y)};
        *(GAS f32x2*)(xres + (size_t)row * D + col) = v; *(GAS unsigned*)(ob + (size_t)row * D + col) = pk2(v.x, v.y);
        float ss = v.x * v.x + v.y * v.y;
#pragma unroll
        for (int o = 1; o < 32; o <<= 1) ss += __shfl_xor(ss, o);
        if ((tid & 31) == 0) ssq[(size_t)row * 16 + cb] = ss; }
}

__device__ __forceinline__ void final_norm_phase(Frame& F, const Args& A) {
    const int gw = F.vcu * NWAVES + F.wave, NGW = F.G * NWAVES;
    const float* SSQ = (const float*)(F.ws + WS_SSQ);
    f32x4 g[4];
#pragma unroll
    for (int j = 0; j < 4; ++j) g[j] = ((const GAS f32x4*)A.in[I_FNG])[F.lane + 64 * j];
    for (int m = gw; m < MROWS; m += NGW) {
        float s = (F.lane < 16) ? SSQ[(size_t)m * 16 + F.lane] : 0.f;
        s = wave_sum(s);
        const float rs = __builtin_amdgcn_rsqf(s * (1.0f / D) + EPS);
        GAS f32x4* xr = (GAS f32x4*)(F.out + (size_t)m * D) + F.lane;
#pragma unroll
        for (int j = 0; j < 4; ++j) { const f32x4 v = xr[64 * j]; xr[64 * j] = v * rs * g[j]; }
    }
}

__global__ void __launch_bounds__(NWAVES * 64, 2) mk_fwd(Args args) {
    extern __shared__ __attribute__((aligned(16))) unsigned char lds[];
    Frame F;
    F.lds = (LAS unsigned char*)lds;
    F.MISC = (volatile LAS unsigned*)(F.lds + MISC_OFF);
    F.tid = threadIdx.x; F.lane = F.tid & 63; F.wave = __builtin_amdgcn_readfirstlane(F.tid >> 6);
    F.G = gridDim.x; { const int bx = blockIdx.x; F.vcu = (F.G % 8 == 0) ? (bx % 8) * (F.G / 8) + bx / 8 : bx; }
    F.ws = args.ws; F.out = args.out;
    F.ctl = (gu32*)(args.ws + WS_CTL);
    for (int u = F.tid; u < (LDS_BYTES - LDSCTL_OFF) / 4; u += NWAVES * 64) ((LAS unsigned*)(F.lds + LDSCTL_OFF))[u] = 0u;
    __syncthreads();
    XcdBarrier bar; bar.bar = (unsigned*)(F.ctl + CW_BAR); bar.x = 0; bar.st = nullptr;
    if (N_LAUNCHES == 1) bar = xcd_barrier_post((unsigned*)(F.ctl + CW_BAR), F.MISC + 8);
#define GRID_BAR() do { if (N_LAUNCHES == 1) xcd_barrier(bar); } while (0)
    const int lo = args.ph_lo, hi = args.ph_hi;
#define IN(k) (lo <= (k) && (k) < hi)
#define BOTH(k) (IN(k) && IN((k) + 1))
    float* SSQ = (float*)(F.ws + WS_SSQ);
    if (IN(0)) {
#ifndef SKIP_P0
        p0_prologue(F, args);
#endif
        if (BOTH(0)) GRID_BAR(); }
#pragma unroll 1
    for (int l = 0; l < 2; ++l) {
        const int pb = 1 + 4 * l;
        bf16* XBA = ws_bf(F, WS_XBA); bf16* XBB = ws_bf(F, WS_XBB);
        if (IN(pb)) {
            pg8::Gemm g{XBA, ws_bf(F, WS_WIN + l * WIN_STRIDE), MT, NIN, D}; pg8::StaticOrder S; S.init(MT, NIN, F.G, (int)blockIdx.x);
            EpiIn E{ws_bf(F, WS_T), SSQ, F.out, l};
#ifndef SKIP_GIN
            pg8::gemm_phase<EpiIn, pg8::StaticOrder, PG8_ALIGN, PG8_SP2>(F.lds + RING_OFF, g, S, E);
#endif
            if (BOTH(pb)) GRID_BAR();
        }
        if (IN(pb + 1)) {
#ifndef SKIP_MIX
            mixer_phase(F, args, l);
#endif
            if (BOTH(pb + 1)) GRID_BAR(); }
        if (IN(pb + 2)) {
#ifndef SKIP_SKINNY
            for (int task = (int)blockIdx.x; task < 256; task += (int)gridDim.x) {
              if (task < 128) skinny_task<0, 4>(F, task, ws_bf(F, WS_Y) + (size_t)MP * D, ws_bf(F, WS_WOUT + l * W1K_STRIDE), D, l == 0 ? args.in[I_XS] : F.out + (size_t)MP * D, F.out, XBB, nullptr, nullptr);
              else skinny_task<1, 1>(F, task - 128, ws_bf(F, WS_PE + l * PE_STRIDE) + (size_t)MP * PLED, ws_bf(F, WS_WPLE + l * WPLE_STRIDE), PLED, nullptr, nullptr, ws_bf(F, WS_PLEO), nullptr, nullptr);
              __syncthreads(); }
#endif
            { pg8::Gemm g{ws_bf(F, WS_Y), ws_bf(F, WS_WOUT + l * W1K_STRIDE), MP, D, D}; pg8::StaticOrder S; S.init(MP, D, F.G, (int)blockIdx.x);
              EpiOut E{args.in[I_XP], args.in[I_XS], F.out, XBB, l};
#ifndef SKIP_GOUT
              pg8::gemm_phase<EpiOut, pg8::StaticOrder, PG8_ALIGN, PG8_SP2>(F.lds + RING_OFF, g, S, E);
#endif
            }
            { pg8::Gemm g{ws_bf(F, WS_PE + l * PE_STRIDE), ws_bf(F, WS_WPLE + l * WPLE_STRIDE), MP, D, PLED}; pg8::StaticOrder S; S.init(MP, D, F.G, (int)blockIdx.x);
              EpiPlain E{ws_bf(F, WS_PLEO)};
#ifndef SKIP_GPLE
              pg8::gemm_phase<EpiPlain, pg8::StaticOrder, PG8_ALIGN, PG8_SP2>(F.lds + RING_OFF, g, S, E);
#endif
            }
            if (BOTH(pb + 2)) GRID_BAR();
        }
        if (IN(pb + 3)) {
#ifndef SKIP_SKINNY
            for (int task = (int)blockIdx.x; task < 128; task += (int)gridDim.x) {
              skinny_task<2, 4>(F, task, XBB + (size_t)MP * D, ws_bf(F, WS_WG + l * W1K_STRIDE), D, nullptr, F.out, XBA, ws_bf(F, WS_PLEO), SSQ);
              __syncthreads(); }
#endif
            pg8::Gemm g{XBB, ws_bf(F, WS_WG + l * W1K_STRIDE), MP, D, D}; pg8::StaticOrder S; S.init(MP, D, F.G, (int)blockIdx.x);
            EpiGate E{F.out, ws_bf(F, WS_PLEO), XBA, SSQ};
#ifndef SKIP_GGATE
            pg8::gemm_phase<EpiGate, pg8::StaticOrder, PG8_ALIGN, PG8_SP2>(F.lds + RING_OFF, g, S, E);
#endif
            if (BOTH(pb + 3)) GRID_BAR();
        }
    }
#ifndef SKIP_FN
    if (IN(9)) final_norm_phase(F, args);
#endif
#undef IN
#undef BOTH
}

extern "C" void kernel_launch(void* const* d_in, const int* in_sizes, int n_in, void* d_out, int out_size, void* d_ws, size_t ws_size, hipStream_t stream) {
    static int grid = 0;
    if (grid == 0) {
        if (n_in != 20 || out_size != (int)O_END || ws_size < WS_END) { fprintf(stderr, "kernel_launch: unexpected shapes: n_in %d out %d ws %zu\n", n_in, out_size, ws_size); grid = -1; return; }
        int dev = 0, cus = 0, per_cu = 0;
        if (hipGetDevice(&dev) != hipSuccess || hipDeviceGetAttribute(&cus, hipDeviceAttributeMultiprocessorCount, dev) != hipSuccess) { grid = -1; return; }
        if (hipFuncSetAttribute((const void*)mk_fwd, hipFuncAttributeMaxDynamicSharedMemorySize, LDS_BYTES) != hipSuccess) { fprintf(stderr, "kernel_launch: hipFuncSetAttribute failed\n"); grid = -1; return; }
        if (hipOccupancyMaxActiveBlocksPerMultiprocessor(&per_cu, (const void*)mk_fwd, NWAVES * 64, LDS_BYTES) != hipSuccess || per_cu < 1)
            fprintf(stderr, "kernel_launch: occupancy query reports %d workgroups per CU\n", per_cu);
        (void)hipGetLastError();
        grid = cus;
    }
    if (grid < 0) return;
    (void)hipMemsetAsync((char*)d_ws + WS_CTL, 0, CTL_ZERO_BYTES, stream);
    Args a{};
    for (int i = 0; i < 20; ++i) a.in[i] = (const float*)d_in[i];
    a.out = (float*)d_out; a.ws = (unsigned char*)d_ws;
    if (N_LAUNCHES == 1) { a.ph_lo = 0; a.ph_hi = N_PHASES; a.li = 0; hipLaunchKernelGGL(mk_fwd, dim3(grid), dim3(NWAVES * 64), LDS_BYTES, stream, a); }
    else for (int li = 0; li < N_PHASES; ++li) { a.ph_lo = li; a.ph_hi = li + 1; a.li = li; hipLaunchKernelGGL(mk_fwd, dim3(grid), dim3(NWAVES * 64), LDS_BYTES, stream, a); }
}
```

```cpp
#include <hip/hip_runtime.h>
#include <cstdio>
#include <cstdint>

#ifndef MK_N_LAUNCHES
#define MK_N_LAUNCHES 1
#endif

namespace pg8 {
#define PG8_LAS __attribute__((address_space(3)))
typedef unsigned short bf16_t;
typedef short bf16x8 __attribute__((ext_vector_type(8)));
typedef float f32x4 __attribute__((ext_vector_type(4)));
typedef unsigned u32x4 __attribute__((ext_vector_type(4)));
typedef unsigned u32x2 __attribute__((ext_vector_type(2)));
constexpr int BM = 256, BK = 64, HALF = 128, HTB = HALF * BK * 2  , STAGE_BYTES = 8 * HTB, NXCD = 8, WGM = 8;

__host__ __device__ __forceinline__ int lds_byte(int r, int c) { const int st = (r >> 4) * 2 + (c >> 5), rr = r & 15, cc = c & 31, ob = rr * 64 + cc * 2; return st * 1024 + (ob ^ (((ob >> 9) & 1) << 5)); }
__host__ __device__ __forceinline__ void stage_rc(int b, int& R, int& C) { const int st = b / 1024, sb = b % 1024, swz = sb ^ (((sb >> 9) & 1) << 5); R = (st >> 1) * 16 + swz / 64; C = (st & 1) * 32 + (swz % 64) / 2; }
__host__ __device__ __forceinline__ int perm32(int rho) { const int n = rho >> 4, i = rho & 15; return 8 * (i >> 2) + 4 * n + (i & 3); }

struct Unit { int pm, pn; };
struct Gemm { const bf16_t* A; const bf16_t* Bt; int M, N, K; };

struct StaticOrder {
    int nM, nN, nwg, G, c;
    __host__ __device__ void init(int M, int N, int G_, int c_) { nM = M / BM; nN = N / BM; nwg = nM * nN; G = G_; c = c_; }
    __host__ __device__ bool next(int i, Unit& u) const {
        const long L = (long)i * G + c; if (L >= nwg) return false;
        int wgid = (int)L; { const int q = nwg / NXCD, r = nwg % NXCD, xcd = wgid % NXCD, off = wgid / NXCD; wgid = (xcd < r ? xcd * (q + 1) : r * (q + 1) + (xcd - r) * q) + off; }
        const int nig = WGM * nN, gid = wgid / nig, fm = gid * WGM, gsz = (nM - fm) < WGM ? (nM - fm) : WGM;
        u.pm = fm + ((wgid % nig) % gsz); u.pn = (wgid % nig) / gsz; return true;
    }
    __device__ __forceinline__ void a_ready(const Unit&) const {}
    __device__ __forceinline__ void done(const Unit&) const {}
};

__device__ __forceinline__ unsigned cvt_pk_bf16(float lo, float hi) { unsigned r; asm volatile("v_cvt_pk_bf16_f32 %0, %1, %2" : "=v"(r) : "v"(lo), "v"(hi)); return r; }

template <class Epi, class Sched, bool ALIGN_EPI = false, bool SP2 = false>
__device__ __forceinline__ void gemm_phase(PG8_LAS unsigned char* lds, const Gemm g, const Sched& S, const Epi& E) {
    int tz0; asm volatile("s_mov_b32 %0, 0" : "=s"(tz0));
    const int tid = threadIdx.x + tz0, wid = __builtin_amdgcn_readfirstlane(tid >> 6), lane = tid & 63, wr = wid >> 2, wc = wid & 3, fr = lane & 15, fq = lane >> 4;
    const int K = g.K, nt = K / BK;
    unsigned voffA[2], voffB[2];
#pragma unroll
    for (int i = 0; i < 2; ++i) { int R, C; stage_rc(tid * 16 + i * 8192, R, C); const int Rb = Epi::PERM ? ((R & ~31) + perm32(R & 31)) : R;
        voffA[i] = (unsigned)(R * K + C) * 2u; voffB[i] = (unsigned)(Rb * K + C) * 2u; }
    const size_t kstep = (size_t)(BK * 2);
    const size_t hstep = (size_t)HALF * K * 2;
    const size_t tstep = 2 * hstep;
    const unsigned ldsw = (unsigned)wid * 1024u;
    const int aoff = lds_byte(wr * 64 + fr, fq * 8), boff = lds_byte(wc * 32 + fr, fq * 8);
#define PG8_SA(b, h) (((b) * 2 + (h)) * HTB)
#define PG8_SB(b, h) ((4 + (b) * 2 + (h)) * HTB)
#define PG8_STAGE(bufoff, gbase, voff) do { _Pragma("unroll") for (int _i = 0; _i < 2; ++_i) \
        __builtin_amdgcn_global_load_lds((const unsigned*)((const char*)(gbase) + (voff)[_i]), (PG8_LAS unsigned*)(lds + (bufoff) + ldsw + _i * 8192), 16, 0, 0); } while (0)
#define PG8_LDA(dst, b, h) do { _Pragma("unroll") for (int m = 0; m < 4; ++m) _Pragma("unroll") for (int k = 0; k < 2; ++k) dst[m][k] = *(const PG8_LAS bf16x8*)(lds + PG8_SA(b, h) + aoff + m * 2048 + k * 1024); } while (0)
#define PG8_LDB(dst, b, h) do { _Pragma("unroll") for (int n = 0; n < 2; ++n) _Pragma("unroll") for (int k = 0; k < 2; ++k) dst[n][k] = *(const PG8_LAS bf16x8*)(lds + PG8_SB(b, h) + boff + n * 2048 + k * 1024); } while (0)
#define PG8_MMA(ai, bj, At, Bt) do { __builtin_amdgcn_s_setprio(1); _Pragma("unroll") for (int m = 0; m < 4; ++m) _Pragma("unroll") for (int n = 0; n < 2; ++n) _Pragma("unroll") for (int k = 0; k < 2; ++k) \
        acc[ai][bj][m][n] = __builtin_amdgcn_mfma_f32_16x16x32_bf16(Bt[n][k], At[m][k], acc[ai][bj][m][n], 0, 0, 0); __builtin_amdgcn_s_setprio(0); } while (0)
#define PG8_WAIT_V(n) asm volatile("s_waitcnt vmcnt(" #n ")" ::: "memory")
#define PG8_WAIT_L(n) asm volatile("s_waitcnt lgkmcnt(" #n ")" ::: "memory")
#define PG8_BAR __builtin_amdgcn_s_barrier()
#define PG8_SCHED __builtin_amdgcn_sched_barrier(0)
    Unit cur, nxt; int ui = 0;
    if (!S.next(0, cur)) return;
    f32x4 acc[2][2][4][2];
#pragma unroll
    for (int a = 0; a < 2; ++a)
#pragma unroll
        for (int b = 0; b < 2; ++b)
#pragma unroll
            for (int m = 0; m < 4; ++m)
#pragma unroll
                for (int n = 0; n < 2; ++n) acc[a][b][m][n] = (f32x4){0.f, 0.f, 0.f, 0.f};
    bf16x8 At[4][2], B0[2][2], B1[2][2];
    const char* cA = (const char*)g.A + (size_t)cur.pm * tstep; const char* cB = (const char*)g.Bt + (size_t)cur.pn * tstep;
    S.a_ready(cur);
    if constexpr (SP2) {
        PG8_STAGE(PG8_SB(0, 0), cB, voffB); PG8_STAGE(PG8_SB(0, 1), cB + hstep, voffB); PG8_STAGE(PG8_SA(0, 0), cA, voffA); PG8_STAGE(PG8_SA(0, 1), cA + hstep, voffA);
        if (wr == 1) PG8_BAR;
        PG8_WAIT_V(2); PG8_BAR;
        PG8_STAGE(PG8_SB(1, 0), cB + kstep, voffB); PG8_STAGE(PG8_SA(1, 0), cA + kstep, voffA); PG8_STAGE(PG8_SB(1, 1), cB + hstep + kstep, voffB);
        PG8_WAIT_V(6); PG8_BAR;
    } else {
        PG8_STAGE(PG8_SB(0, 0), cB, voffB); PG8_STAGE(PG8_SA(0, 0), cA, voffA); PG8_STAGE(PG8_SB(0, 1), cB + hstep, voffB); PG8_STAGE(PG8_SA(0, 1), cA + hstep, voffA);
        if (wr == 1) PG8_BAR;
        PG8_WAIT_V(4); PG8_BAR;
        PG8_STAGE(PG8_SB(1, 0), cB + kstep, voffB); PG8_STAGE(PG8_SA(1, 0), cA + kstep, voffA); PG8_STAGE(PG8_SB(1, 1), cB + hstep + kstep, voffB);
        PG8_WAIT_V(6); PG8_BAR;
    }
    for (;;) {
        const bool has_next = S.next(ui + 1, nxt);
        const char* nA = has_next ? (const char*)g.A + (size_t)nxt.pm * tstep : cA; const char* nB = has_next ? (const char*)g.Bt + (size_t)nxt.pn * tstep : cB;
#pragma unroll 1
        for (int t = 0; t < nt; t += 2) {
            const bool last = (t == nt - 2);
            const char* a1 = cA + (size_t)(t + 1) * kstep;
            const char* a2 = last ? nA : cA + (size_t)(t + 2) * kstep; const char* b2 = last ? nB : cB + (size_t)(t + 2) * kstep;
            const char* a3 = a2 + kstep; const char* b3 = b2 + kstep;
            if (last && has_next) S.a_ready(nxt);
            if constexpr (SP2) {
            PG8_LDB(B0, 0, 0); PG8_LDB(B1, 0, 1); PG8_SCHED; PG8_LDA(At, 0, 0); PG8_STAGE(PG8_SA(1, 1), a1 + hstep, voffA);
            PG8_WAIT_V(8); PG8_WAIT_L(0); PG8_BAR; PG8_MMA(0, 0, At, B0); PG8_MMA(0, 1, At, B1); PG8_BAR; PG8_SCHED;
            PG8_LDA(At, 0, 1); PG8_STAGE(PG8_SB(0, 0), b2, voffB); PG8_STAGE(PG8_SB(0, 1), b2 + hstep, voffB); PG8_STAGE(PG8_SA(0, 0), a2, voffA);
            PG8_WAIT_V(8); PG8_WAIT_L(0); PG8_BAR; PG8_MMA(1, 0, At, B0); PG8_MMA(1, 1, At, B1); PG8_BAR; PG8_SCHED;
            PG8_LDB(B0, 1, 0); PG8_LDB(B1, 1, 1); PG8_SCHED; PG8_LDA(At, 1, 0); PG8_STAGE(PG8_SA(0, 1), a2 + hstep, voffA);
            PG8_WAIT_V(8); PG8_WAIT_L(0); PG8_BAR; PG8_MMA(0, 0, At, B0); PG8_MMA(0, 1, At, B1); PG8_BAR; PG8_SCHED;
            PG8_LDA(At, 1, 1); PG8_STAGE(PG8_SB(1, 0), b3, voffB); PG8_STAGE(PG8_SB(1, 1), b3 + hstep, voffB); PG8_STAGE(PG8_SA(1, 0), a3, voffA);
            PG8_WAIT_V(8); PG8_WAIT_L(0); PG8_BAR; PG8_MMA(1, 0, At, B0); PG8_MMA(1, 1, At, B1); PG8_BAR; PG8_SCHED;
            } else {
            PG8_LDB(B0, 0, 0); PG8_SCHED; PG8_LDA(At, 0, 0); PG8_STAGE(PG8_SA(1, 1), a1 + hstep, voffA);
            PG8_WAIT_L(8); PG8_BAR; PG8_WAIT_L(0); PG8_MMA(0, 0, At, B0); PG8_BAR; PG8_SCHED;
            PG8_LDB(B1, 0, 1); PG8_STAGE(PG8_SB(0, 0), b2, voffB);
            PG8_BAR; PG8_WAIT_L(0); PG8_MMA(0, 1, At, B1); PG8_BAR;
            PG8_LDA(At, 0, 1); PG8_STAGE(PG8_SA(0, 0), a2, voffA);
            PG8_BAR; PG8_WAIT_L(0); PG8_MMA(1, 0, At, B0); PG8_BAR; PG8_SCHED;
            PG8_STAGE(PG8_SB(0, 1), b2 + hstep, voffB);
            PG8_WAIT_V(6); PG8_BAR; PG8_MMA(1, 1, At, B1); PG8_BAR;
            PG8_LDB(B0, 1, 0); PG8_SCHED; PG8_LDA(At, 1, 0); PG8_STAGE(PG8_SA(0, 1), a2 + hstep, voffA);
            PG8_WAIT_L(8); PG8_BAR; PG8_WAIT_L(0); PG8_MMA(0, 0, At, B0); PG8_BAR; PG8_SCHED;
            PG8_LDB(B1, 1, 1); PG8_STAGE(PG8_SB(1, 0), b3, voffB);
            PG8_BAR; PG8_WAIT_L(0); PG8_MMA(0, 1, At, B1); PG8_BAR;
            PG8_LDA(At, 1, 1); PG8_STAGE(PG8_SA(1, 0), a3, voffA);
            PG8_BAR; PG8_WAIT_L(0); PG8_MMA(1, 0, At, B0); PG8_BAR; PG8_SCHED;
            PG8_STAGE(PG8_SB(1, 1), b3 + hstep, voffB);
            PG8_WAIT_V(6); PG8_BAR; PG8_MMA(1, 1, At, B1); PG8_BAR;
            }
        }
        if constexpr (ALIGN_EPI) { if (wr == 0) PG8_BAR; }
        E(acc, cur, wr, wc, fr, fq); S.done(cur);
        if (!has_next) break;
#pragma unroll
        for (int a = 0; a < 2; ++a)
#pragma unroll
            for (int b = 0; b < 2; ++b)
#pragma unroll
                for (int m = 0; m < 4; ++m)
#pragma unroll
                    for (int n = 0; n < 2; ++n) acc[a][b][m][n] = (f32x4){0.f, 0.f, 0.f, 0.f};
        cur = nxt; cA = nA; cB = nB; ++ui;
        if constexpr (ALIGN_EPI) { if (wr == 1) PG8_BAR; }
    }
    PG8_WAIT_V(0);
    if constexpr (!ALIGN_EPI) { if (wr == 0) PG8_BAR; }
    PG8_BAR;
#undef PG8_SA
#undef PG8_SB
#undef PG8_STAGE
#undef PG8_LDA
#undef PG8_LDB
#undef PG8_MMA
#undef PG8_WAIT_V
#undef PG8_WAIT_L
#undef PG8_BAR
#undef PG8_SCHED
}
}

#ifndef PG8_SP2
#define PG8_SP2 true
#endif
#ifndef PG8_ALIGN
#define PG8_ALIGN true
#endif

constexpr int NWAVES = 8;
constexpr int N_LAUNCHES = MK_N_LAUNCHES;
constexpr int N_PHASES = 10;
constexpr int D = 1024, NB = 8, SEQ = 2048, MP = NB * SEQ  , NS = 128, MROWS = MP + NS  , MT = 65 * 256  ;
constexpr int WA = 256, WB = 384, WC = 384, INC = 3200, NIN = 13 * 256  , PLED = 256, TW = 2048  ;
constexpr float EPS = 1e-6f;
constexpr int T_VA = 0, T_SZA = 256, T_UB = 512, T_SZB = 896, T_UC = 1280, T_BZ = 1664;
constexpr size_t O_Y = 0, O_POOLP = (size_t)MROWS * D, O_POOLS = O_POOLP + 2 * 8 * 15 * 256, O_CONVP = O_POOLS + 2 * 128 * 15 * 256, O_CONVS = O_CONVP + 2 * 8 * 30 * 384,
                 O_SCP = O_CONVS + 2 * 128 * 30 * 384, O_SCS = O_SCP + 2 * 8 * 2 * 384, O_END = O_SCS + 2 * 128 * 2 * 384;
constexpr size_t MiB = 1u << 20;
constexpr size_t WS_CTL = 0, CTL_ZERO_BYTES = 1 * MiB;
constexpr size_t WS_WIN = 2 * MiB, WIN_STRIDE = 7 * MiB;
constexpr size_t WS_WOUT = 16 * MiB, WS_WG = 20 * MiB, W1K_STRIDE = 2 * MiB;
constexpr size_t WS_WPLE = 24 * MiB, WPLE_STRIDE = MiB / 2;
constexpr size_t WS_SSQ = 25 * MiB;
constexpr size_t WS_PSB = 27 * MiB, WS_PSA = WS_PSB + 2 * 128 * 384 * 4, WS_PSC = WS_PSA + 2 * 128 * 256 * 4;
constexpr size_t WS_PE = 28 * MiB, PE_STRIDE = 9 * MiB;
constexpr size_t WS_XBA = 46 * MiB, WS_XBB = 79 * MiB, WS_Y = 112 * MiB, WS_PLEO = 145 * MiB;
constexpr size_t WS_T = 178 * MiB;
constexpr size_t WS_END = 243 * MiB;
static_assert((size_t)NIN * D * 2 <= WIN_STRIDE && (size_t)MT * 16 * 4 <= 3 * MiB && (size_t)MT * 256 * 2 <= PE_STRIDE && (size_t)MT * D * 2 <= 33 * MiB && (size_t)MT * TW * 2 <= 65 * MiB, "ws map");
constexpr int CW_BAR = 4096;
constexpr int RING_OFF = 0, RING_BYTES = 131072;
constexpr int LDS_BYTES = 147456;
constexpr int LDSCTL_OFF = LDS_BYTES - 256, MISC_OFF = LDSCTL_OFF;

#define GAS __attribute__((address_space(1)))
#define LAS __attribute__((address_space(3)))
typedef unsigned short bf16;
typedef unsigned v4u __attribute__((ext_vector_type(4)));
typedef unsigned v2u __attribute__((ext_vector_type(2)));
typedef float f32x4 __attribute__((ext_vector_type(4)));
typedef float f32x2 __attribute__((ext_vector_type(2)));
typedef GAS unsigned gu32;
#define RLX_AGENT __ATOMIC_RELAXED, __HIP_MEMORY_SCOPE_AGENT
#define LDS_WAIT() asm volatile("s_waitcnt lgkmcnt(0)" ::: "memory")
#define VM_WAIT() asm volatile("s_waitcnt vmcnt(0)" ::: "memory")
__device__ __forceinline__ unsigned f2bf(float f) { unsigned u = __builtin_bit_cast(unsigned, f); return (u + 0x7fffu + ((u >> 16) & 1u)) >> 16; }
__device__ __forceinline__ unsigned pk2(float lo, float hi) { return f2bf(lo) | (f2bf(hi) << 16); }
__device__ __forceinline__ float bf_lo(unsigned u) { return __builtin_bit_cast(float, u << 16); }
__device__ __forceinline__ float bf_hi(unsigned u) { return __builtin_bit_cast(float, u & 0xffff0000u); }
__device__ __forceinline__ float sigmoidf_(float x) { return __builtin_amdgcn_rcpf(1.0f + __expf(-x)); }
__device__ __forceinline__ float siluf_(float x) { return x * sigmoidf_(x); }

#define XB_TMO      128
#define XB_XCNT(j)  (256  + 64 * (j))
#define XB_XSUB(j)  (1280 + 64 * (j))
#define XB_XGEN(j)  (2304 + 64 * (j))
#define XB_TOP      3328
#define XB_TOPGEN   3392
#define XCD_BAR_WORDS 3456
#define XB_SPIN_CAP (1u << 18)
__device__ __forceinline__ unsigned xb_ld(unsigned* p)              { return __hip_atomic_load(p, __ATOMIC_RELAXED, __HIP_MEMORY_SCOPE_AGENT); }
__device__ __forceinline__ unsigned xb_add(unsigned* p, unsigned v) { return __hip_atomic_fetch_add(p, v, __ATOMIC_RELAXED, __HIP_MEMORY_SCOPE_AGENT); }
__device__ __forceinline__ unsigned xb_xcc_id() { return (unsigned)__builtin_amdgcn_s_getreg((3 << 11) | 20) & 0xFu; }
#define XB_SPIN(cond, bar) do { unsigned _sp = 0; while (cond) { __builtin_amdgcn_s_sleep(1); \
    if ((++_sp & 255u) == 0u) { if (xb_ld(&(bar)[XB_TMO])) break; if (_sp > XB_SPIN_CAP) { atomicAdd(&(bar)[XB_TMO], 1u); break; } } } } while (0)
struct XcdBarrier { unsigned* bar; unsigned x; volatile LAS unsigned* st; };
__device__ __forceinline__ XcdBarrier xcd_barrier_post(unsigned* bar, volatile LAS unsigned* st) {
    XcdBarrier b; b.bar = bar; b.x = xb_xcc_id(); b.st = st;
    if (threadIdx.x == 0) (void)xb_add(&bar[XB_XCNT(b.x)], 1u);
    return b;
}
__device__ __forceinline__ void xcd_barrier_complete(unsigned* bar, unsigned x, unsigned& nloc, unsigned& nx) {
    const unsigned G = gridDim.x * gridDim.y * gridDim.z;
    unsigned sum, cnt, mine, sp = 0u;
    for (;;) {
        sum = 0u; cnt = 0u; mine = 0u;
#pragma unroll
        for (unsigned j = 0; j < 16; ++j) { const unsigned c = xb_ld(&bar[XB_XCNT(j)]); sum += c; cnt += (c > 0u) ? 1u : 0u; mine = (j == x) ? c : mine; }
        if (sum == G) break;
        __builtin_amdgcn_s_sleep(1);
        if ((++sp & 255u) == 0u) { if (xb_ld(&bar[XB_TMO])) break; if (sp > XB_SPIN_CAP) { atomicAdd(&bar[XB_TMO], 1u); break; } }
    }
    nloc = mine > 0u ? mine : 1u; nx = cnt > 0u ? cnt : 1u;
}
__device__ __forceinline__ void xcd_barrier(const XcdBarrier& b) {
    asm volatile("s_waitcnt vmcnt(0)" ::: "memory");
    __syncthreads();
    if (threadIdx.x == 0) {
        unsigned* bar = b.bar;
        __builtin_amdgcn_s_waitcnt(0);
        unsigned nloc = b.st[0], nx = b.st[1];
        if (nloc == 0u) { xcd_barrier_complete(bar, b.x, nloc, nx); b.st[0] = nloc; b.st[1] = nx; }
        const unsigned old = xb_add(&bar[XB_XSUB(b.x)], 1u);
        const unsigned gen = old / nloc;
        if (old + 1u == (gen + 1u) * nloc) {
            __builtin_amdgcn_fence(__ATOMIC_RELEASE, "agent");
            asm volatile("s_waitcnt vmcnt(0)" ::: "memory");
            const unsigned og = xb_add(&bar[XB_TOP], 1u);
            const unsigned tg = og / nx;
            if (og + 1u == (tg + 1u) * nx) xb_add(&bar[XB_TOPGEN], 1u);
            else XB_SPIN(xb_ld(&bar[XB_TOPGEN]) == tg, bar);
            __builtin_amdgcn_fence(__ATOMIC_ACQUIRE, "agent");
            xb_add(&bar[XB_XGEN(b.x)], 1u);
            asm volatile("s_waitcnt vmcnt(0)" ::: "memory");
        } else {
            XB_SPIN(xb_ld(&bar[XB_XGEN(b.x)]) == gen, bar);
            __builtin_amdgcn_fence(__ATOMIC_ACQUIRE, "agent");
            asm volatile("s_waitcnt vmcnt(0)" ::: "memory");
        }
    }
    __syncthreads();
}

struct Args { const float* in[20]; float* out; unsigned char* ws; int ph_lo, ph_hi, li, pad; };
enum { I_XP = 0, I_XS, I_SPOOL, I_SCONV, I_SSCONV, I_PP, I_PS, I_NORMG, I_WIN, I_WMIX, I_PSCALE, I_CBW, I_CBB, I_LNG, I_LNB, I_SCW, I_WOUT, I_WPLE, I_WGATE, I_FNG };
struct Frame {
    LAS unsigned char* lds;
    volatile LAS unsigned* MISC;
    gu32* ctl;
    int tid, lane, wave;
    int vcu, G;
    float* out;
    unsigned char* ws;
};
__device__ __forceinline__ bf16* ws_bf(const Frame& F, size_t off) { return (bf16*)(F.ws + off); }

__device__ __forceinline__ float wave_sum(float v) {
#pragma unroll
    for (int o = 1; o < 64; o <<= 1) v += __shfl_xor(v, o);
    return v;
}

using pg8::Unit; using pg8::cvt_pk_bf16;
__device__ __forceinline__ v4u pack8(const f32x4 a, const f32x4 b) { v4u w; w.x = cvt_pk_bf16(a[0], a[1]); w.y = cvt_pk_bf16(a[2], a[3]); w.z = cvt_pk_bf16(b[0], b[1]); w.w = cvt_pk_bf16(b[2], b[3]); return w; }
__device__ __forceinline__ f32x4 sig4(const f32x4 v) { return (f32x4){sigmoidf_(v[0]), sigmoidf_(v[1]), sigmoidf_(v[2]), sigmoidf_(v[3])}; }
__device__ __forceinline__ f32x4 silu4(const f32x4 v) { return v * sig4(v); }

__device__ __forceinline__ float* state_ptr(float* out, int layer, int row, int H, int C, size_t offP, size_t offS) {
    if (row < MP) { const int b = row >> 11, t = row & 2047, j = t - (SEQ - H); if (j < 0) return nullptr; return out + offP + ((size_t)(layer * NB + b) * H + j) * C; }
    const int s = row - MP; if (s >= NS) return nullptr; return out + offS + ((size_t)(layer * NS + s) * H + (H - 1)) * C;
}

struct EpiIn {
    static constexpr bool PERM = true, AFTER_DRAIN = false;
    bf16* T; const float* ssq; float* out; int layer;
    __device__ __forceinline__ void operator()(const f32x4 (&acc)[2][2][4][2], const Unit& u, int wr, int wc, int fr, int fq) const {
        const int pn = u.pn, pm = u.pm, cl = wc * 32 + 8 * fq, rowb = pm * 256 + wr * 64 + fr;
        const bool has_state = (pm == 64) || ((pm & 7) == 7);
        int ty, oc0, oc1 = 0, sc0 = 0;
        if (pn < 3) { ty = 0; oc0 = T_UB + 128 * pn; sc0 = 128 * pn; }
        else if (pn < 6) { ty = 1; oc0 = T_UC + 128 * (pn - 3); sc0 = 128 * (pn - 3); }
        else if (pn < 9) { ty = 2; oc0 = T_BZ + 128 * (pn - 6); }
        else if (pn == 9) { ty = 3; oc0 = T_VA; oc1 = T_VA + 128; }
        else if (pn == 10) { ty = 4; oc0 = T_SZA; oc1 = T_SZA + 128; }
        else if (pn == 11) { ty = 4; oc0 = T_SZB; oc1 = T_SZB + 128; }
        else { ty = 5; oc0 = T_SZB + 256; }
#pragma unroll
        for (int ai = 0; ai < 2; ++ai)
#pragma unroll
            for (int m = 0; m < 4; ++m) {
                const int row = rowb + ai * 128 + m * 16;
                const f32x4* sp = (const f32x4*)(ssq + (size_t)row * 16);
                const f32x4 s0 = sp[0], s1 = sp[1], s2 = sp[2], s3 = sp[3];
                const float ss = ((s0[0] + s0[1]) + (s0[2] + s0[3])) + ((s1[0] + s1[1]) + (s1[2] + s1[3])) + ((s2[0] + s2[1]) + (s2[2] + s2[3])) + ((s3[0] + s3[1]) + (s3[2] + s3[3]));
                const float rs = __builtin_amdgcn_rsqf(ss * (1.0f / D) + EPS);
                const f32x4 h0a = acc[ai][0][m][0] * rs, h0b = acc[ai][0][m][1] * rs, h1a = acc[ai][1][m][0] * rs, h1b = acc[ai][1][m][1] * rs;
                bf16* trow = T + (size_t)row * TW + cl;
                if (ty == 0 || ty == 1 || ty == 2) {
                    f32x4 oa, ob;
                    if (ty == 0) { oa = h0a * sig4(h1a); ob = h0b * sig4(h1b); }
                    else if (ty == 1) { oa = h0a * h1a; ob = h0b * h1b; }
                    else { oa = h0a * silu4(h1a); ob = h0b * silu4(h1b); }
                    *(v4u*)(trow + oc0) = pack8(oa, ob);
                    if (has_state && ty != 2) {
                        float* p = (ty == 0) ? state_ptr(out, layer, row, 30, 384, O_CONVP, O_CONVS) : state_ptr(out, layer, row, 2, 384, O_SCP, O_SCS);
                        if (p) { *(f32x4*)(p + sc0 + cl) = oa; *(f32x4*)(p + sc0 + cl + 4) = ob; }
                    }
                } else if (ty == 3) {
                    *(v4u*)(trow + oc0) = pack8(h0a, h0b); *(v4u*)(trow + oc1) = pack8(h1a, h1b);
                    if (has_state) { float* p = state_ptr(out, layer, row, 15, 256, O_POOLP, O_POOLS);
                        if (p) { *(f32x4*)(p + cl) = h0a; *(f32x4*)(p + cl + 4) = h0b; *(f32x4*)(p + 128 + cl) = h1a; *(f32x4*)(p + 128 + cl + 4) = h1b; } }
                } else if (ty == 4) {
                    *(v4u*)(trow + oc0) = pack8(silu4(h0a), silu4(h0b)); *(v4u*)(trow + oc1) = pack8(silu4(h1a), silu4(h1b));
                } else {
                    *(v4u*)(trow + oc0) = pack8(silu4(h0a), silu4(h0b));
                }
            }
    }
};

__device__ __forceinline__ void unpack8(const v4u w, f32x4& a, f32x4& b) { a = (f32x4){bf_lo(w.x), bf_hi(w.x), bf_lo(w.y), bf_hi(w.y)}; b = (f32x4){bf_lo(w.z), bf_hi(w.z), bf_lo(w.w), bf_hi(w.w)}; }
struct EpiOut {
    static constexpr bool PERM = true, AFTER_DRAIN = false;
    const bf16* xin; bf16* xout;
    __device__ __forceinline__ void operator()(const f32x4 (&acc)[2][2][4][2], const Unit& u, int wr, int wc, int fr, int fq) const {
        const int cl = u.pn * 256 + wc * 32 + 8 * fq, rowb = u.pm * 256 + wr * 64 + fr;
#pragma unroll
        for (int ai = 0; ai < 2; ++ai)
#pragma unroll
            for (int m = 0; m < 4; ++m) {
                const size_t ro = (size_t)(rowb + ai * 128 + m * 16) * D + cl;
#pragma unroll
                for (int bj = 0; bj < 2; ++bj) { f32x4 a, b; unpack8(*(const v4u*)(xin + ro + bj * 128), a, b);
                    *(v4u*)(xout + ro + bj * 128) = pack8(acc[ai][bj][m][0] + a, acc[ai][bj][m][1] + b); }
            }
    }
};

struct EpiPlain {
    static constexpr bool PERM = true, AFTER_DRAIN = false;
    bf16* O;
    __device__ __forceinline__ void operator()(const f32x4 (&acc)[2][2][4][2], const Unit& u, int wr, int wc, int fr, int fq) const {
        const int cl = u.pn * 256 + wc * 32 + 8 * fq, rowb = u.pm * 256 + wr * 64 + fr;
#pragma unroll
        for (int ai = 0; ai < 2; ++ai)
#pragma unroll
            for (int m = 0; m < 4; ++m) { const int row = rowb + ai * 128 + m * 16;
#pragma unroll
                for (int bj = 0; bj < 2; ++bj) *(v4u*)(O + (size_t)row * D + cl + bj * 128) = pack8(acc[ai][bj][m][0], acc[ai][bj][m][1]); }
    }
};

struct EpiGate {
    static constexpr bool PERM = true, AFTER_DRAIN = false;
    const bf16* xin; const bf16* ple; bf16* xout; float* ssq;
    __device__ __forceinline__ void operator()(const f32x4 (&acc)[2][2][4][2], const Unit& u, int wr, int wc, int fr, int fq) const {
        const int cl = u.pn * 256 + wc * 32 + 8 * fq, rowb = u.pm * 256 + wr * 64 + fr;
#pragma unroll
        for (int ai = 0; ai < 2; ++ai)
#pragma unroll
            for (int m = 0; m < 4; ++m) {
                const int row = rowb + ai * 128 + m * 16; const size_t ro = (size_t)row * D + cl;
                float ss = 0.f;
#pragma unroll
                for (int bj = 0; bj < 2; ++bj) { f32x4 a, b, pa, pb; unpack8(*(const v4u*)(xin + ro + bj * 128), a, b); unpack8(*(const v4u*)(ple + ro + bj * 128), pa, pb);
                    const f32x4 v0 = a + pa * sig4(acc[ai][bj][m][0]), v1 = b + pb * sig4(acc[ai][bj][m][1]);
                    ss += (v0[0] * v0[0] + v0[1] * v0[1]) + (v0[2] * v0[2] + v0[3] * v0[3]) + (v1[0] * v1[0] + v1[1] * v1[1]) + (v1[2] * v1[2] + v1[3] * v1[3]);
                    *(v4u*)(xout + ro + bj * 128) = pack8(v0, v1); }
                ss += __shfl_xor(ss, 16); ss += __shfl_xor(ss, 32);
                if (fq == 0) ssq[(size_t)row * 16 + u.pn * 4 + wc] = ss;
            }
    }
};

__device__ __forceinline__ int in_half_src(int hh) {
    const int t = hh >> 1, h = hh & 1;
    if (t < 3) return (h ? 896 : 512) + 128 * t;
    if (t < 6) return (h ? 1664 : 2432) + 128 * (t - 3);
    if (t < 9) return (h ? 2816 : 2048) + 128 * (t - 6);
    if (t == 9) return h ? 128 : 0;
    if (t == 10) return h ? 384 : 256;
    if (t == 11) return h ? 1408 : 1280;
    return 1536;
}
__device__ __forceinline__ void p0_transpose_item(const float* W, int K, int N, int src_n0, bf16* WT, int dst_row0, const float* gscale, LAS float* scr, int k0, int lane) {
#pragma unroll 8
    for (int i = 0; i < 32; ++i) { const int kk = 2 * i + (lane >> 5); float w = W[(size_t)(k0 + kk) * N + src_n0 + (lane & 31)]; if (gscale) w *= gscale[k0 + kk]; scr[kk * 33 + (lane & 31)] = w; }
    LDS_WAIT(); asm volatile("" ::: "memory");
    const int c = lane & 7;
#pragma unroll
    for (int j = 0; j < 4; ++j) { const int n = (lane >> 3) + 8 * j; const LAS float* s = scr + (8 * c) * 33 + n;
        v4u o; o.x = pk2(s[0 * 33], s[1 * 33]); o.y = pk2(s[2 * 33], s[3 * 33]); o.z = pk2(s[4 * 33], s[5 * 33]); o.w = pk2(s[6 * 33], s[7 * 33]);
        *(GAS v4u*)(WT + (size_t)(dst_row0 + n) * K + k0 + 8 * c) = o; }
    LDS_WAIT(); asm volatile("" ::: "memory");
}
__device__ __forceinline__ void p0_prologue(Frame& F, const Args& A) {
    LAS float* scr = (LAS float*)(F.lds + RING_OFF + F.wave * 16384);
    const int gw = F.vcu * NWAVES + F.wave, NGW = F.G * NWAVES;
    constexpr int I_IN = 16 * 104, I_SQ = 16 * 32, I_PLE = 4 * 32, I_L = I_IN + 2 * I_SQ + I_PLE, NITEMS = 2 * I_L;
    for (int it = gw; it < NITEMS; it += NGW) {
        const int l = it / I_L; int r = it % I_L;
        if (r < I_IN) { const int kb = r / 104, nb = r % 104; p0_transpose_item(A.in[I_WIN] + (size_t)l * D * INC, D, INC, in_half_src(nb >> 2) + 32 * (nb & 3), ws_bf(F, WS_WIN + l * WIN_STRIDE), 32 * nb, A.in[I_NORMG] + l * D, scr, 64 * kb, F.lane); continue; } r -= I_IN;
        if (r < I_SQ) { const int kb = r / 32, nb = r % 32; p0_transpose_item(A.in[I_WOUT] + (size_t)l * D * D, D, D, 32 * nb, ws_bf(F, WS_WOUT + l * W1K_STRIDE), 32 * nb, nullptr, scr, 64 * kb, F.lane); continue; } r -= I_SQ;
        if (r < I_SQ) { const int kb = r / 32, nb = r % 32; p0_transpose_item(A.in[I_WGATE] + (size_t)l * D * D, D, D, 32 * nb, ws_bf(F, WS_WG + l * W1K_STRIDE), 32 * nb, nullptr, scr, 64 * kb, F.lane); continue; } r -= I_SQ;
        { const int kb = r / 32, nb = r % 32; p0_transpose_item(A.in[I_WPLE] + (size_t)l * PLED * D, PLED, D, 32 * nb, ws_bf(F, WS_WPLE + l * WPLE_STRIDE), 32 * nb, nullptr, scr, 64 * kb, F.lane); }
    }
    bf16* XB = ws_bf(F, WS_XBA); float* SSQ = (float*)(F.ws + WS_SSQ);
    for (int m = gw; m < MROWS; m += NGW) {
        const float* xrow = m < MP ? A.in[I_XP] + (size_t)m * D : A.in[I_XS] + (size_t)(m - MP) * D;
        const GAS f32x4* xr = (const GAS f32x4*)xrow + F.lane;
        f32x4 v[4]; float s = 0.f;
#pragma unroll
        for (int j = 0; j < 4; ++j) { v[j] = xr[64 * j]; s += (v[j].x * v[j].x + v[j].y * v[j].y) + (v[j].z * v[j].z + v[j].w * v[j].w); }
        s = wave_sum(s);
        GAS v2u* o8 = (GAS v2u*)(XB + (size_t)m * D) + F.lane;
#pragma unroll
        for (int j = 0; j < 4; ++j) o8[64 * j] = (v2u){pk2(v[j].x, v[j].y), pk2(v[j].z, v[j].w)};
        if (F.lane < 16) SSQ[(size_t)m * 16 + F.lane] = (F.lane == 0) ? s : 0.f;
    }
    for (int it = gw; it < 2 * MROWS; it += NGW) {
        const int l = it / MROWS, m = it % MROWS;
        const float* prow = m < MP ? A.in[I_PP] + ((size_t)l * MP + m) * PLED : A.in[I_PS] + ((size_t)l * NS + (m - MP)) * PLED;
        const f32x4 v = ((const GAS f32x4*)prow)[F.lane];
        ((GAS v2u*)(ws_bf(F, WS_PE + l * PE_STRIDE) + (size_t)m * PLED))[F.lane] = (v2u){pk2(v.x, v.y), pk2(v.z, v.w)};
    }
    { const int gt0 = F.vcu * (NWAVES * 64) + F.tid, NGT0 = F.G * NWAVES * 64;
      for (int i = gt0; i < 2 * NS * (192 + 128 + 192); i += NGT0) {
          if (i < 2 * NS * 192) { const int ls = i / 192, ch = 2 * (i % 192), l = ls / NS;
              const float* st = A.in[I_SCONV] + (size_t)ls * 30 * WB + ch; const float* cw = A.in[I_CBW] + (size_t)l * 31 * WB + ch;
              f32x2 a = *(const GAS f32x2*)(A.in[I_CBB] + l * WB + ch);
#pragma unroll 10
              for (int k = 0; k < 30; ++k) a += *(const GAS f32x2*)(cw + k * WB) * *(const GAS f32x2*)(st + k * WB);
              *(GAS f32x2*)((float*)(F.ws + WS_PSB) + (size_t)ls * WB + ch) = a; }
          else if (i < 2 * NS * 320) { const int i2 = i - 2 * NS * 192, ls = i2 / 128, cp = i2 % 128, ch = 2 * cp, w = 2 << (cp >> 5);
              const float* st = A.in[I_SPOOL] + (size_t)ls * 15 * WA + ch; f32x2 a = (f32x2){0.f, 0.f};
              for (int j = 1; j < w; ++j) a += *(const GAS f32x2*)(st + (15 - j) * WA);
              *(GAS f32x2*)((float*)(F.ws + WS_PSA) + (size_t)ls * WA + ch) = a; }
          else { const int i2 = i - 2 * NS * 320, ls = i2 / 192, ch = 2 * (i2 % 192), l = ls / NS;
              const float* st = A.in[I_SSCONV] + (size_t)ls * 2 * WC + ch; const float* w = A.in[I_SCW] + (size_t)l * 3 * WC + ch;
              *(GAS f32x2*)((float*)(F.ws + WS_PSC) + (size_t)ls * WC + ch) = *(const GAS f32x2*)w * *(const GAS f32x2*)st + *(const GAS f32x2*)(w + WC) * *(const GAS f32x2*)(st + WC); }
      } }
    const int gt = F.vcu * (NWAVES * 64) + F.tid, NGT = F.G * NWAVES * 64;
    for (int i = gt; i < 2 * NS * 14 * 64; i += NGT) { const int ls = i / (14 * 64), r = i % (14 * 64);
        ((GAS f32x4*)(F.out + O_POOLS + (size_t)ls * 15 * 256))[r] = ((const GAS f32x4*)(A.in[I_SPOOL] + (size_t)ls * 15 * 256 + 256))[r]; }
    for (int i = gt; i < 2 * NS * 29 * 96; i += NGT) { const int ls = i / (29 * 96), r = i % (29 * 96);
        ((GAS f32x4*)(F.out + O_CONVS + (size_t)ls * 30 * 384))[r] = ((const GAS f32x4*)(A.in[I_SCONV] + (size_t)ls * 30 * 384 + 384))[r]; }
    for (int i = gt; i < 2 * NS * 96; i += NGT) { const int ls = i / 96, r = i % 96;
        ((GAS f32x4*)(F.out + O_SCS + (size_t)ls * 2 * 384))[r] = ((const GAS f32x4*)(A.in[I_SSCONV] + (size_t)ls * 2 * 384 + 384))[r]; }
}

__device__ __forceinline__ int opaque0() { int z; asm volatile("s_mov_b32 %0, 0" : "=s"(z)); return z; }
__device__ __forceinline__ f32x2 ldbf2(const bf16* p) { const unsigned u = *(const GAS unsigned*)p; return (f32x2){bf_lo(u), bf_hi(u)}; }
typedef short bf16x8_t __attribute__((ext_vector_type(8)));
constexpr int MX_CWS = 0, MX_UBS = 47616, MX_VAS = 82944, MX_CB = 98816, MX_PLB = 123392, MX_PRM = 131840, MX_END = MX_PRM + 2560 * 4, PLB_LD = 264;
constexpr int MX_NCH_UB = 46 * 48, MX_NCH = MX_NCH_UB + 31 * 32;
static_assert(MX_END <= LDSCTL_OFF, "mixer LDS map");
__device__ __forceinline__ void mixer_phase(Frame& F, const Args& A, int layer) {
    LAS float* CWS = (LAS float*)(F.lds + MX_CWS);
    LAS unsigned* UBS = (LAS unsigned*)(F.lds + MX_UBS);
    LAS unsigned* VAS = (LAS unsigned*)(F.lds + MX_VAS);
    LAS float* CB = (LAS float*)(F.lds + MX_CB);
    LAS bf16* PLB = (LAS bf16*)(F.lds + MX_PLB);
    LAS float* PRM = (LAS float*)(F.lds + MX_PRM);
    LAS float* cbias = PRM; LAS float* lg = PRM + 384; LAS float* lb = PRM + 768; LAS float* sw = PRM + 1152; LAS float* psc = PRM + 2304;
    const bf16* T = ws_bf(F, WS_T); bf16* Y = ws_bf(F, WS_Y);
    const int tid = F.tid + opaque0(), lane = tid & 63, wave = F.wave, fr = lane & 15, fq = lane >> 4;
    { const GAS f32x4* cwg = (const GAS f32x4*)(A.in[I_CBW] + (size_t)layer * 31 * WB);
      for (int i = tid; i < 31 * 96; i += 512) ((LAS f32x4*)CWS)[i] = cwg[i];
      if (tid < 384) { cbias[tid] = A.in[I_CBB][layer * WB + tid]; lg[tid] = A.in[I_LNG][layer * WB + tid]; lb[tid] = A.in[I_LNB][layer * WB + tid]; }
      for (int i = tid; i < 3 * 384; i += 512) sw[i] = A.in[I_SCW][layer * 3 * WC + i];
      if (tid < 256) psc[tid] = A.in[I_PSCALE][layer * WA + tid]; }
    bf16x8_t wf[2][2];
    { const float* wm = A.in[I_WMIX] + (size_t)layer * 16384 + (size_t)(wave >> 1) * 4096;
#pragma unroll
      for (int a = 0; a < 2; ++a)
#pragma unroll
          for (int ks = 0; ks < 2; ++ks) { const float* p = wm + (32 * ks + 8 * fq) * 64 + 16 * (2 * (wave & 1) + a) + fr;
              v4u w; w.x = pk2(p[0], p[64]); w.y = pk2(p[128], p[192]); w.z = pk2(p[256], p[320]); w.w = pk2(p[384], p[448]); wf[a][ks] = __builtin_bit_cast(bf16x8_t, w); } }
    const float* PSB = (const float*)(F.ws + WS_PSB) + (size_t)layer * NS * WB; const float* PSA = (const float*)(F.ws + WS_PSA) + (size_t)layer * NS * WA; const float* PSC = (const float*)(F.ws + WS_PSC) + (size_t)layer * NS * WC;
    v4u pf[7];
#define MX_PREFETCH(uu) do { const int r0_ = (uu) * 16, t0_ = r0_ & 2047; _Pragma("unroll") for (int i_ = 0; i_ < 7; ++i_) { const int c_ = tid + 512 * i_; v4u v_ = (v4u){0u, 0u, 0u, 0u}; \
        if (c_ < MX_NCH_UB) { const int j_ = c_ / 48, cc_ = c_ % 48; if (t0_ - 30 + j_ >= 0) v_ = *(const GAS v4u*)(T + (size_t)(r0_ - 30 + j_) * TW + T_UB + cc_ * 8); } \
        else if (c_ < MX_NCH) { const int c2_ = c_ - MX_NCH_UB, j_ = c2_ >> 5, cc_ = c2_ & 31; if (t0_ - 15 + j_ >= 0) v_ = *(const GAS v4u*)(T + (size_t)(r0_ - 15 + j_) * TW + T_VA + cc_ * 8); } \
        pf[i_] = v_; } } while (0)
    int u = blockIdx.x;
    if (u < 1024) MX_PREFETCH(u);
    for (; u < 1032; u += gridDim.x) {
        const bool smp = u >= 1024;
        const int row0 = smp ? MP + (u - 1024) * 16 : u * 16;
        const int t0 = smp ? 0 : (row0 & 2047);
        __syncthreads();
        if (!smp) {
#pragma unroll
            for (int i = 0; i < 7; ++i) { const int c = tid + 512 * i;
                if (c < MX_NCH_UB) *(LAS v4u*)(UBS + 4 * c) = pf[i]; else if (c < MX_NCH) *(LAS v4u*)(VAS + 4 * (c - MX_NCH_UB)) = pf[i]; }
        }
        const int tze = tid + opaque0();
        unsigned zb[2][3]; v2u zz[2];
#pragma unroll
        for (int q = 0; q < 2; ++q)
#pragma unroll
            for (int j = 0; j < 3; ++j) zb[q][j] = *(const GAS unsigned*)(T + (size_t)(row0 + 2 * wave + q) * TW + T_SZB + 128 * j + 2 * (tze & 63));
#pragma unroll
        for (int a = 0; a < 2; ++a) zz[a] = *(const GAS v2u*)(T + (size_t)(row0 + (tze & 15)) * TW + T_SZA + 64 * (wave >> 1) + 16 * (2 * (wave & 1) + a) + 4 * ((tze & 63) >> 4));
        { const int un = u + gridDim.x; if (un < 1024) MX_PREFETCH(un); }
        __syncthreads();
        if (tid < 384) {
            const int tz = tid + opaque0(), cp = tz % 192, tb = tz / 192, ch = 2 * cp;
            if (!smp) {
                const f32x2 bias = *(const LAS f32x2*)(cbias + ch);
                const LAS unsigned* ub = UBS + (8 * tb) * 192 + cp;
                f32x2 in[38];
#pragma unroll
                for (int j = 0; j < 38; ++j) { const unsigned w = ub[j * 192]; in[j] = (f32x2){bf_lo(w), bf_hi(w)}; }
                f32x2 a[8];
#pragma unroll
                for (int i = 0; i < 8; ++i) a[i] = bias;
#pragma unroll
                for (int k = 0; k < 31; ++k) { const f32x2 w = *(const LAS f32x2*)(CWS + k * WB + ch);
#pragma unroll
                    for (int i = 0; i < 8; ++i) a[i] += w * in[i + k]; }
#pragma unroll
                for (int i = 0; i < 8; ++i) *(LAS f32x2*)(CB + (8 * tb + i) * WB + ch) = a[i];
            } else {
                const f32x2 w30 = *(const LAS f32x2*)(CWS + 30 * WB + ch);
#pragma unroll
                for (int i = 0; i < 8; ++i) { const int s = (u - 1024) * 16 + 8 * tb + i;
                    *(LAS f32x2*)(CB + (8 * tb + i) * WB + ch) = *(const GAS f32x2*)(PSB + (size_t)s * WB + ch) + w30 * ldbf2(T + (size_t)(MP + s) * TW + T_UB + ch); }
            }
        }
        { const int lz = lane + opaque0();
#pragma unroll
          for (int q = 0; q < 4; ++q) { const int wt = wave + 8 * q, g = wt & 3, tk = 2 * (wt >> 2) + (lz >> 5), cp = 32 * g + (lz & 31), w = 2 << g;
              f32x2 s, v;
              if (!smp) { const LAS unsigned* vr = VAS + (15 + tk) * 128 + cp; const unsigned x0 = vr[0]; v = (f32x2){bf_lo(x0), bf_hi(x0)}; s = v;
                  for (int j = 1; j < w; ++j) { const unsigned x = vr[-j * 128]; s += (f32x2){bf_lo(x), bf_hi(x)}; }
                  const int t = t0 + tk; s = s * (1.0f / (float)(w < t + 1 ? w : t + 1)); }
              else { const int sq = (u - 1024) * 16 + tk; v = ldbf2(T + (size_t)(MP + sq) * TW + T_VA + 2 * cp); s = (*(const GAS f32x2*)(PSA + (size_t)sq * WA + 2 * cp) + v) * (1.0f / (float)w); }
              s = s - v;
              *(LAS unsigned*)(PLB + tk * PLB_LD + 2 * cp) = pk2(s.x, s.y); } }
        __syncthreads();
        unsigned eu0[6], eu1[6], eu2[6], ebz[6];
#pragma unroll
        for (int q = 0; q < 6; ++q) { const int task = tze + 512 * q, tk = task / 192, cp = task % 192, ch = 2 * cp, row = row0 + tk, t = t0 + tk;
            const bf16* p = T + (size_t)row * TW + T_UC + ch;
            eu0[q] = *(const GAS unsigned*)p; ebz[q] = *(const GAS unsigned*)(p + (T_BZ - T_UC));
            eu1[q] = (!smp && t >= 1) ? *(const GAS unsigned*)(p - TW) : 0u; eu2[q] = (!smp && t >= 2) ? *(const GAS unsigned*)(p - 2 * TW) : 0u; }
        { const int lz = lane + opaque0();
#pragma unroll
          for (int q = 0; q < 2; ++q) { const int tk = 2 * wave + q, row = row0 + tk;
            f32x2 x[3]; float s = 0.f;
#pragma unroll
            for (int j = 0; j < 3; ++j) { x[j] = *(LAS f32x2*)(CB + tk * WB + 128 * j + 2 * lz); s += x[j].x + x[j].y; }
            const float mean = wave_sum(s) * (1.0f / WB); float s2 = 0.f;
#pragma unroll
            for (int j = 0; j < 3; ++j) { x[j] = x[j] - mean; s2 += x[j].x * x[j].x + x[j].y * x[j].y; }
            const float rstd = __builtin_amdgcn_rsqf(wave_sum(s2) * (1.0f / WB) + EPS);
#pragma unroll
            for (int j = 0; j < 3; ++j) { const int ch = 128 * j + 2 * lz;
                const f32x2 g = *(const LAS f32x2*)(lg + ch), b = *(const LAS f32x2*)(lb + ch);
                const f32x2 y = x[j] * rstd * g + b;
                *(GAS unsigned*)(Y + (size_t)row * D + WA + ch) = pk2(siluf_(y.x) * bf_lo(zb[q][j]), siluf_(y.y) * bf_hi(zb[q][j])); }
          } }
        { const int g = wave >> 1;
          const bf16x8_t p0 = *(const LAS bf16x8_t*)(PLB + fr * PLB_LD + 64 * g + 8 * fq), p1 = *(const LAS bf16x8_t*)(PLB + fr * PLB_LD + 64 * g + 32 + 8 * fq);
#pragma unroll
          for (int a = 0; a < 2; ++a) {
              f32x4 acc = (f32x4){0.f, 0.f, 0.f, 0.f};
              acc = __builtin_amdgcn_mfma_f32_16x16x32_bf16(wf[a][0], p0, acc, 0, 0, 0);
              acc = __builtin_amdgcn_mfma_f32_16x16x32_bf16(wf[a][1], p1, acc, 0, 0, 0);
              const int ch = 64 * g + 16 * (2 * (wave & 1) + a) + 4 * fq, row = row0 + fr;
              const f32x4 sc = *(const LAS f32x4*)(psc + ch);
              *(GAS v2u*)(Y + (size_t)row * D + ch) = (v2u){pk2(acc[0] * sc[0] * bf_lo(zz[a].x), acc[1] * sc[1] * bf_hi(zz[a].x)), pk2(acc[2] * sc[2] * bf_lo(zz[a].y), acc[3] * sc[3] * bf_hi(zz[a].y))}; } }
#pragma unroll
        for (int q = 0; q < 6; ++q) { const int task = tze + 512 * q, tk = task / 192, cp = task % 192, ch = 2 * cp, row = row0 + tk;
            const f32x2 w2 = *(const LAS f32x2*)(sw + 2 * WC + ch); f32x2 s = w2 * (f32x2){bf_lo(eu0[q]), bf_hi(eu0[q])};
            if (!smp) s += *(const LAS f32x2*)(sw + ch) * (f32x2){bf_lo(eu2[q]), bf_hi(eu2[q])} + *(const LAS f32x2*)(sw + WC + ch) * (f32x2){bf_lo(eu1[q]), bf_hi(eu1[q])};
            else s += *(const GAS f32x2*)(PSC + (size_t)(row - MP) * WC + ch);
            *(GAS unsigned*)(Y + (size_t)row * D + WA + WB + ch) = pk2(s.x * bf_lo(ebz[q]), s.y * bf_hi(ebz[q])); }
    }
#undef MX_PREFETCH
    __syncthreads();
}

template <int MODE, int KSTEPS  >
__device__ __forceinline__ void skinny_task(Frame& F, int task, const bf16* A, const bf16* Bt, int K, const bf16* xin, bf16* ob, const bf16* ple, float* ssq) {
    const int tid = F.tid + opaque0(), lane = tid & 63, wave = F.wave, fr = lane & 15, fq = lane >> 4;
    const int rb = task >> 4, cb = task & 15;
    LAS float* P = (LAS float*)(F.lds + RING_OFF);
    const bf16* ap = A + (size_t)(rb * 16 + fr) * K + wave * (KSTEPS * 32) + 8 * fq;
    const bf16* bp = Bt + (size_t)(cb * 64 + fr) * K + wave * (KSTEPS * 32) + 8 * fq;
    bf16x8_t af[KSTEPS], bfr[4][KSTEPS];
#pragma unroll
    for (int ks = 0; ks < KSTEPS; ++ks) { af[ks] = *(const GAS bf16x8_t*)(ap + 32 * ks);
#pragma unroll
        for (int ct = 0; ct < 4; ++ct) bfr[ct][ks] = *(const GAS bf16x8_t*)(bp + (size_t)(16 * ct) * K + 32 * ks); }
    __syncthreads();
#pragma unroll
    for (int ct = 0; ct < 4; ++ct) { f32x4 acc = (f32x4){0.f, 0.f, 0.f, 0.f};
#pragma unroll
        for (int ks = 0; ks < KSTEPS; ++ks) acc = __builtin_amdgcn_mfma_f32_16x16x32_bf16(bfr[ct][ks], af[ks], acc, 0, 0, 0);
        *(LAS f32x4*)(P + (wave * 16 + fr) * 64 + 16 * ct + 4 * fq) = acc; }
    __syncthreads();
    const int r = tid >> 5, c2 = (tid & 31) * 2;
    f32x2 v = (f32x2){0.f, 0.f};
#pragma unroll
    for (int w = 0; w < 8; ++w) v += *(const LAS f32x2*)(P + (w * 16 + r) * 64 + c2);
    const int row = MP + rb * 16 + r, col = cb * 64 + c2;
    if (MODE == 0) { v += ldbf2(xin + (size_t)row * D + col); *(GAS unsigned*)(ob + (size_t)row * D + col) = pk2(v.x, v.y); }
    else if (MODE == 1) { *(GAS unsigned*)(ob + (size_t)row * D + col) = pk2(v.x, v.y); }
    else { const f32x2 x = ldbf2(xin + (size_t)row * D + col), p = ldbf2(ple + (size_t)row * D + col);
        v = x + p * (f32x2){sigmoidf_(v.x), sigmoidf_(v.y)};
        *(GAS unsigned*)(ob + (size_t)row * D + col) = pk2(v.x, v.y);
        float ss = v.x * v.x + v.y * v.y;
#pragma unroll
        for (int o = 1; o < 32; o <<= 1) ss += __shfl_xor(ss, o);
        if ((tid & 31) == 0) ssq[(size_t)row * 16 + cb] = ss; }
}

__device__ __forceinline__ void final_norm_phase(Frame& F, const Args& A) {
    const int gw = F.vcu * NWAVES + F.wave, NGW = F.G * NWAVES;
    const float* SSQ = (const float*)(F.ws + WS_SSQ); const bf16* XB = ws_bf(F, WS_XBA);
    f32x4 g[4];
#pragma unroll
    for (int j = 0; j < 4; ++j) g[j] = ((const GAS f32x4*)A.in[I_FNG])[F.lane + 64 * j];
    for (int m = gw; m < MROWS; m += NGW) {
        float s = (F.lane < 16) ? SSQ[(size_t)m * 16 + F.lane] : 0.f;
        s = wave_sum(s);
        const float rs = __builtin_amdgcn_rsqf(s * (1.0f / D) + EPS);
        const GAS v2u* xr = (const GAS v2u*)(XB + (size_t)m * D) + F.lane;
        GAS f32x4* yr = (GAS f32x4*)(F.out + (size_t)m * D) + F.lane;
#pragma unroll
        for (int j = 0; j < 4; ++j) { const v2u w = xr[64 * j]; yr[64 * j] = (f32x4){bf_lo(w.x), bf_hi(w.x), bf_lo(w.y), bf_hi(w.y)} * rs * g[j]; }
    }
}

__global__ void __launch_bounds__(NWAVES * 64, 2) mk_fwd(Args args) {
    extern __shared__ __attribute__((aligned(16))) unsigned char lds[];
    Frame F;
    F.lds = (LAS unsigned char*)lds;
    F.MISC = (volatile LAS unsigned*)(F.lds + MISC_OFF);
    F.tid = threadIdx.x; F.lane = F.tid & 63; F.wave = __builtin_amdgcn_readfirstlane(F.tid >> 6);
    F.G = gridDim.x; { const int bx = blockIdx.x; F.vcu = (F.G % 8 == 0) ? (bx % 8) * (F.G / 8) + bx / 8 : bx; }
    F.ws = args.ws; F.out = args.out;
    F.ctl = (gu32*)(args.ws + WS_CTL);
    for (int u = F.tid; u < (LDS_BYTES - LDSCTL_OFF) / 4; u += NWAVES * 64) ((LAS unsigned*)(F.lds + LDSCTL_OFF))[u] = 0u;
    __syncthreads();
    XcdBarrier bar; bar.bar = (unsigned*)(F.ctl + CW_BAR); bar.x = 0; bar.st = nullptr;
    if (N_LAUNCHES == 1) bar = xcd_barrier_post((unsigned*)(F.ctl + CW_BAR), F.MISC + 8);
#define GRID_BAR() do { if (N_LAUNCHES == 1) xcd_barrier(bar); } while (0)
    const int lo = args.ph_lo, hi = args.ph_hi;
#define IN(k) (lo <= (k) && (k) < hi)
#define BOTH(k) (IN(k) && IN((k) + 1))
    float* SSQ = (float*)(F.ws + WS_SSQ);
    if (IN(0)) {
#ifndef SKIP_P0
        p0_prologue(F, args);
#endif
        if (BOTH(0)) GRID_BAR(); }
#pragma unroll 1
    for (int l = 0; l < 2; ++l) {
        const int pb = 1 + 4 * l;
        bf16* XBA = ws_bf(F, WS_XBA); bf16* XBB = ws_bf(F, WS_XBB);
        if (IN(pb)) {
            pg8::Gemm g{XBA, ws_bf(F, WS_WIN + l * WIN_STRIDE), MT, NIN, D}; pg8::StaticOrder S; S.init(MT, NIN, F.G, (int)blockIdx.x);
            EpiIn E{ws_bf(F, WS_T), SSQ, F.out, l};
#ifndef SKIP_GIN
            pg8::gemm_phase<EpiIn, pg8::StaticOrder, PG8_ALIGN, PG8_SP2>(F.lds + RING_OFF, g, S, E);
#endif
            if (BOTH(pb)) GRID_BAR();
        }
        if (IN(pb + 1)) {
#ifndef SKIP_MIX
            mixer_phase(F, args, l);
#endif
            if (BOTH(pb + 1)) GRID_BAR(); }
        if (IN(pb + 2)) {
#ifndef SKIP_SKINNY
            for (int task = (int)blockIdx.x; task < 256; task += (int)gridDim.x) {
              if (task < 128) skinny_task<0, 4>(F, task, ws_bf(F, WS_Y) + (size_t)MP * D, ws_bf(F, WS_WOUT + l * W1K_STRIDE), D, XBA, XBB, nullptr, nullptr);
              else skinny_task<1, 1>(F, task - 128, ws_bf(F, WS_PE + l * PE_STRIDE) + (size_t)MP * PLED, ws_bf(F, WS_WPLE + l * WPLE_STRIDE), PLED, nullptr, ws_bf(F, WS_PLEO), nullptr, nullptr);
              __syncthreads(); }
#endif
            { pg8::Gemm g{ws_bf(F, WS_Y), ws_bf(F, WS_WOUT + l * W1K_STRIDE), MP, D, D}; pg8::StaticOrder S; S.init(MP, D, F.G, (int)blockIdx.x);
              EpiOut E{XBA, XBB};
#ifndef SKIP_GOUT
              pg8::gemm_phase<EpiOut, pg8::StaticOrder, PG8_ALIGN, PG8_SP2>(F.lds + RING_OFF, g, S, E);
#endif
            }
            { pg8::Gemm g{ws_bf(F, WS_PE + l * PE_STRIDE), ws_bf(F, WS_WPLE + l * WPLE_STRIDE), MP, D, PLED}; pg8::StaticOrder S; S.init(MP, D, F.G, (int)blockIdx.x);
              EpiPlain E{ws_bf(F, WS_PLEO)};
#ifndef SKIP_GPLE
              pg8::gemm_phase<EpiPlain, pg8::StaticOrder, PG8_ALIGN, PG8_SP2>(F.lds + RING_OFF, g, S, E);
#endif
            }
            if (BOTH(pb + 2)) GRID_BAR();
        }
        if (IN(pb + 3)) {
#ifndef SKIP_SKINNY
            for (int task = (int)blockIdx.x; task < 128; task += (int)gridDim.x) {
              skinny_task<2, 4>(F, task, XBB + (size_t)MP * D, ws_bf(F, WS_WG + l * W1K_STRIDE), D, XBB, XBA, ws_bf(F, WS_PLEO), SSQ);
              __syncthreads(); }
#endif
            pg8::Gemm g{XBB, ws_bf(F, WS_WG + l * W1K_STRIDE), MP, D, D}; pg8::StaticOrder S; S.init(MP, D, F.G, (int)blockIdx.x);
            EpiGate E{XBB, ws_bf(F, WS_PLEO), XBA, SSQ};
#ifndef SKIP_GGATE
            pg8::gemm_phase<EpiGate, pg8::StaticOrder, PG8_ALIGN, PG8_SP2>(F.lds + RING_OFF, g, S, E);
#endif
            if (BOTH(pb + 3)) GRID_BAR();
        }
    }
#ifndef SKIP_FN
    if (IN(9)) final_norm_phase(F, args);
#endif
#undef IN
#undef BOTH
}

extern "C" void kernel_launch(void* const* d_in, const int* in_sizes, int n_in, void* d_out, int out_size, void* d_ws, size_t ws_size, hipStream_t stream) {
    static int grid = 0;
    if (grid == 0) {
        if (n_in != 20 || out_size != (int)O_END || ws_size < WS_END) { fprintf(stderr, "kernel_launch: unexpected shapes: n_in %d out %d ws %zu\n", n_in, out_size, ws_size); grid = -1; return; }
        int dev = 0, cus = 0, per_cu = 0;
        if (hipGetDevice(&dev) != hipSuccess || hipDeviceGetAttribute(&cus, hipDeviceAttributeMultiprocessorCount, dev) != hipSuccess) { grid = -1; return; }
        if (hipFuncSetAttribute((const void*)mk_fwd, hipFuncAttributeMaxDynamicSharedMemorySize, LDS_BYTES) != hipSuccess) { fprintf(stderr, "kernel_launch: hipFuncSetAttribute failed\n"); grid = -1; return; }
        if (hipOccupancyMaxActiveBlocksPerMultiprocessor(&per_cu, (const void*)mk_fwd, NWAVES * 64, LDS_BYTES) != hipSuccess || per_cu < 1)
            fprintf(stderr, "kernel_launch: occupancy query reports %d workgroups per CU\n", per_cu);
        (void)hipGetLastError();
        grid = cus;
    }
    if (grid < 0) return;
    (void)hipMemsetAsync((char*)d_ws + WS_CTL, 0, CTL_ZERO_BYTES, stream);
    Args a{};
    for (int i = 0; i < 20; ++i) a.in[i] = (const float*)d_in[i];
    a.out = (float*)d_out; a.ws = (unsigned char*)d_ws;
    if (N_LAUNCHES == 1) { a.ph_lo = 0; a.ph_hi = N_PHASES; a.li = 0; hipLaunchKernelGGL(mk_fwd, dim3(grid), dim3(NWAVES * 64), LDS_BYTES, stream, a); }
    else for (int li = 0; li < N_PHASES; ++li) { a.ph_lo = li; a.ph_hi = li + 1; a.li = li; hipLaunchKernelGGL(mk_fwd, dim3(grid), dim3(NWAVES * 64), LDS_BYTES, stream, a); }
}
```
